# Optimizing an MI355X kernel written in HIP

```python
import math
import jax
import jax.numpy as jnp
from jax import lax
import numpy as np


D_MODEL = 1024
BATCH = 8
SEQ = 2048
DEPTH = 4

CTX_LEN = 256
GRID_W = 64
HEAD_DIM = 64
ROPE_THETA = 10000.0
EPS = 1e-6
NEG_INF = -1e30
D_FF = 2816
N_BRANCH = 4
BRANCH_W = 256
WA_Q_HEADS = 4
WA_KV_HEADS = 2
WA_WINDOW = 128
WA_BLOCK = 128
NA_HEADS = 4
NA_ROWS = 8
NA_COLS = 16
NA_QCOLS = 16
NA_KCOLS = 32
GA_Q_HEADS = 4
GA_KV_HEADS = 2
GA_BLOCK = 128
SSM_HEADS = 4
SSM_HEAD_DIM = 64
SSM_GROUPS = 2
SSM_STATE = 128
SSM_CONV = 5
SSM_CHUNK = 128
SSM_INNER = SSM_HEADS * SSM_HEAD_DIM
SSM_CONV_CH = SSM_INNER + 2 * SSM_GROUPS * SSM_STATE
IN_SIZES = (WA_Q_HEADS * HEAD_DIM, WA_KV_HEADS * HEAD_DIM, WA_KV_HEADS * HEAD_DIM,
            NA_HEADS * HEAD_DIM, NA_HEADS * HEAD_DIM, NA_HEADS * HEAD_DIM,
            GA_Q_HEADS * HEAD_DIM, GA_KV_HEADS * HEAD_DIM, GA_KV_HEADS * HEAD_DIM,
            SSM_INNER, SSM_CONV_CH, 2 * SSM_HEADS,
            N_BRANCH * D_MODEL)

kernel_name = 'hybrid_flow_backbone'


def rms_norm(x, g):
    xf = x.astype(jnp.float32)
    y = xf * lax.rsqrt(jnp.mean(xf * xf, axis=-1, keepdims=True) + EPS)
    return (y * g.astype(jnp.float32)).astype(x.dtype)


def swiglu(h, wg, wu, wd):
    return (jax.nn.silu(h @ wg) * (h @ wu)) @ wd


def split_heads(t):
    return t.reshape(t.shape[:-1] + (-1, HEAD_DIM))


def rope_tables(seq):
    pos = jnp.arange(seq)
    axes = jnp.stack([pos // GRID_W, pos % GRID_W], axis=-1).astype(jnp.float32)
    quarter = HEAD_DIM // 4
    inv = 1.0 / (ROPE_THETA ** (jnp.arange(quarter, dtype=jnp.float32) * 4.0 / HEAD_DIM))
    ang = axes[:, :, None] * inv
    return jnp.cos(ang), jnp.sin(ang)


def apply_rope(x, cos, sin):
    shp = x.shape
    xs = x.reshape(shp[:-1] + (2, 2, HEAD_DIM // 4))
    x1, x2 = xs[..., 0, :], xs[..., 1, :]
    cs = cos[:, None].astype(x.dtype)
    sn = sin[:, None].astype(x.dtype)
    out = jnp.stack([x1 * cs - x2 * sn, x2 * cs + x1 * sn], axis=-2)
    return out.reshape(shp)


def joint_softmax(parts):
    sizes = [p.shape[-1] for p in parts]
    p = jax.nn.softmax(jnp.concatenate(parts, axis=-1), axis=-1)
    return jnp.split(p, np.cumsum(sizes)[:-1].tolist(), axis=-1)


def context_attention(q, k, v, sink):
    bsz, lq, hq, d = q.shape
    hk = k.shape[2]
    g = hq // hk
    qg = q.reshape(bsz, lq, hk, g, d)
    s = jnp.einsum('bqhgd,bkhd->bhgqk', qg, k).astype(jnp.float32) * d ** -0.5
    if sink is not None:
        s_sink = jnp.broadcast_to(sink.astype(jnp.float32).reshape(1, hk, g, 1, 1), s.shape[:-1] + (1,))
        p, _ = joint_softmax([s, s_sink])
    else:
        p = jax.nn.softmax(s, axis=-1)
    o = jnp.einsum('bhgqk,bkhd->bqhgd', p.astype(v.dtype), v)
    return o.reshape(bsz, lq, hq * d)


def window_attention(q, k, v, kc, vc, sink):
    bsz, seq, hq, d = q.shape
    hk = k.shape[2]
    g = hq // hk
    nb = seq // WA_BLOCK
    scale = d ** -0.5
    qb = q.reshape(bsz, nb, WA_BLOCK, hk, g, d)

    def band(t):
        tp = jnp.pad(t, ((0, 0), (WA_WINDOW, WA_WINDOW), (0, 0), (0, 0))).reshape(bsz, nb + 2, WA_BLOCK, hk, d)
        return jnp.concatenate([tp[:, :-2], tp[:, 1:-1], tp[:, 2:]], axis=2)

    kb, vb = band(k), band(v)
    s_loc = jnp.einsum('bnqhgd,bnkhd->bnhgqk', qb, kb).astype(jnp.float32) * scale
    blk = jnp.arange(nb)[:, None, None] * WA_BLOCK
    qpos = blk + jnp.arange(WA_BLOCK)[None, :, None]
    kpos = blk - WA_WINDOW + jnp.arange(3 * WA_BLOCK)[None, None, :]
    valid = (jnp.abs(qpos - kpos) <= WA_WINDOW) & (kpos >= 0) & (kpos < seq)
    s_loc = jnp.where(valid[None, :, None, None], s_loc, NEG_INF)
    s_ctx = jnp.einsum('bnqhgd,bchd->bnhgqc', qb, kc).astype(jnp.float32) * scale
    s_sink = jnp.broadcast_to(sink.astype(jnp.float32).reshape(1, 1, hk, g, 1, 1), s_ctx.shape[:-1] + (1,))
    p_loc, p_ctx, _ = joint_softmax([s_loc, s_ctx, s_sink])
    o = (jnp.einsum('bnhgqk,bnkhd->bnqhgd', p_loc.astype(vb.dtype), vb)
         + jnp.einsum('bnhgqc,bchd->bnqhgd', p_ctx.astype(vc.dtype), vc))
    return o.reshape(bsz, seq, hq * d)


def neighborhood_attention(q, k, v, kc, vc, rpb):
    bsz, seq, h, d = q.shape
    rows = seq // GRID_W
    rw = min(NA_ROWS, rows)
    ncb = GRID_W // NA_QCOLS
    scale = d ** -0.5
    r = jnp.arange(rows)
    row_start = jnp.clip(r - rw // 2, 0, rows - rw)
    idx_r = row_start[:, None] + jnp.arange(rw)[None, :]
    qcol = jnp.arange(ncb)[:, None] * NA_QCOLS + jnp.arange(NA_QCOLS)[None, :]
    qcol_start = jnp.clip(qcol - NA_COLS // 2, 0, GRID_W - NA_COLS)
    kcol_start = jnp.clip(jnp.arange(ncb) * NA_QCOLS - NA_COLS // 2, 0, GRID_W - NA_KCOLS)
    idx_c = kcol_start[:, None] + jnp.arange(NA_KCOLS)[None, :]
    nk = rw * NA_KCOLS

    def gather(t):
        tg = t.reshape(bsz, rows, GRID_W, h, d)
        return tg[:, idx_r[:, None, :, None], idx_c[None, :, None, :]].reshape(bsz, rows, ncb, nk, h, d)

    kn, vn = gather(k), gather(v)
    qg = q.reshape(bsz, rows, ncb, NA_QCOLS, h, d)
    col_ok = (idx_c[:, None, :] >= qcol_start[:, :, None]) & (idx_c[:, None, :] < qcol_start[:, :, None] + NA_COLS)
    col_ok = jnp.broadcast_to(col_ok[:, :, None, :], (ncb, NA_QCOLS, rw, NA_KCOLS)).reshape(ncb, NA_QCOLS, nk)
    dr = idx_r - r[:, None] + NA_ROWS - 1
    dc = jnp.clip(idx_c[:, None, :] - qcol[:, :, None] + NA_COLS - 1, 0, 2 * NA_COLS - 2)
    bias = rpb[:, dr[:, None, None, :, None], dc[None, :, :, None, :]]
    bias = bias.reshape(h, rows, ncb, NA_QCOLS, nk).transpose(1, 2, 0, 3, 4).astype(jnp.float32)
    s_nb = jnp.einsum('brjqhd,brjkhd->brjhqk', qg, kn).astype(jnp.float32) * scale + bias
    s_nb = jnp.where(col_ok[None, None, :, None], s_nb, NEG_INF)
    s_ctx = jnp.einsum('brjqhd,bchd->brjhqc', qg, kc).astype(jnp.float32) * scale
    p_nb, p_ctx = joint_softmax([s_nb, s_ctx])
    o = (jnp.einsum('brjhqk,brjkhd->brjqhd', p_nb.astype(vn.dtype), vn)
         + jnp.einsum('brjhqc,bchd->brjqhd', p_ctx.astype(vc.dtype), vc))
    return o.reshape(bsz, seq, h * d)


def dense_block_attention(q, k, v, kc, vc):
    bsz, seq, hq, d = q.shape
    hk = k.shape[2]
    g = hq // hk
    nb = seq // GA_BLOCK
    scale = d ** -0.5
    qb = q.reshape(bsz, nb, GA_BLOCK, hk, g, d).transpose(1, 0, 2, 3, 4, 5)

    def one_block(qi):
        s_lat = jnp.einsum('bqhgd,bkhd->bhgqk', qi, k).astype(jnp.float32) * scale
        s_ctx = jnp.einsum('bqhgd,bkhd->bhgqk', qi, kc).astype(jnp.float32) * scale
        p_lat, p_ctx = joint_softmax([s_lat, s_ctx])
        return (jnp.einsum('bhgqk,bkhd->bqhgd', p_lat.astype(v.dtype), v)
                + jnp.einsum('bhgqk,bkhd->bqhgd', p_ctx.astype(vc.dtype), vc))

    o = lax.map(one_block, qb)
    return o.transpose(1, 0, 2, 3, 4, 5).reshape(bsz, seq, hq * d)


def segsum(a):
    t = a.shape[-1]
    a_rep = jnp.broadcast_to(a[..., :, None], a.shape + (t,))
    strict = jnp.tril(jnp.ones((t, t), dtype=bool), -1)
    cs = jnp.cumsum(jnp.where(strict, a_rep, 0.0), axis=-2)
    return jnp.where(jnp.tril(jnp.ones((t, t), dtype=bool)), cs, -jnp.inf)


def ssd(x, dt, a, bm, cm, init):
    bsz, seq, h, p = x.shape
    g, n = bm.shape[2], bm.shape[3]
    nc = seq // SSM_CHUNK
    rep = h // g
    f32 = jnp.float32
    bh = jnp.repeat(bm.astype(f32), rep, axis=2).reshape(bsz, nc, SSM_CHUNK, h, n)
    ch = jnp.repeat(cm.astype(f32), rep, axis=2).reshape(bsz, nc, SSM_CHUNK, h, n)
    xdt = (x.astype(f32) * dt[..., None]).reshape(bsz, nc, SSM_CHUNK, h, p)
    da = (dt * a).reshape(bsz, nc, SSM_CHUNK, h).transpose(0, 3, 1, 2)
    da_cum = jnp.cumsum(da, axis=-1)
    decay = jnp.exp(segsum(da))
    scores = jnp.einsum('bclhn,bcshn->bhcls', ch, bh) * decay
    y_diag = jnp.einsum('bhcls,bcshp->bclhp', scores, xdt)
    decay_states = jnp.exp(da_cum[..., -1:] - da_cum)
    states = jnp.einsum('bclhn,bhcl,bclhp->bchpn', bh, decay_states, xdt)
    chunk_decay = jnp.exp(da_cum[..., -1])

    def step(s, inp):
        st, dec = inp
        return s * dec[..., None, None] + st, s

    final, s_in = lax.scan(step, init, (states.transpose(1, 0, 2, 3, 4), chunk_decay.transpose(2, 0, 1)))
    s_in = s_in.transpose(1, 0, 2, 3, 4)
    y_off = jnp.einsum('bclhn,bchpn,bhcl->bclhp', ch, s_in, jnp.exp(da_cum))
    return (y_diag + y_off).reshape(bsz, seq, h, p), final


def depthwise_conv(u, w, b):
    pad = SSM_CONV // 2
    y = lax.conv_general_dilated(u, w.astype(u.dtype)[:, None, :], (1,), [(pad, pad)],
                                 dimension_numbers=('NWC', 'WIO', 'NWC'), feature_group_count=u.shape[-1])
    return y + b.astype(u.dtype)


def ssm_mixer(z, xbc, dt_raw, zc, xbcc, dtc_raw, lp, with_ctx):
    def prep(xbc_, dt_raw_):
        u = jax.nn.silu(depthwise_conv(xbc_, lp['ssm_conv_w'], lp['ssm_conv_b']))
        xs, bm, cm = jnp.split(u, [SSM_INNER, SSM_INNER + SSM_GROUPS * SSM_STATE], axis=-1)
        xs = xs.reshape(xs.shape[:-1] + (SSM_HEADS, SSM_HEAD_DIM))
        bm = bm.reshape(bm.shape[:-1] + (SSM_GROUPS, SSM_STATE))
        cm = cm.reshape(cm.shape[:-1] + (SSM_GROUPS, SSM_STATE))
        dtr = dt_raw_.astype(jnp.float32).reshape(dt_raw_.shape[:-1] + (2, SSM_HEADS))
        dt = jax.nn.softplus(dtr + lp['ssm_dt_bias'].astype(jnp.float32))
        return xs, bm, cm, dt

    a = -jnp.exp(lp['ssm_a_log'].astype(jnp.float32))
    xl, bl, cl, dtl = prep(xbc, dt_raw)
    xc, bc, cc, dtc = prep(xbcc, dtc_raw)
    init = jnp.zeros((xl.shape[0], SSM_HEADS, SSM_HEAD_DIM, SSM_STATE), jnp.float32)
    flip = lambda t: jnp.flip(t, axis=1)
    yc_f, sc_f = ssd(xc, dtc[..., 0, :], a[0], bc, cc, init)
    yl_f, _ = ssd(xl, dtl[..., 0, :], a[0], bl, cl, sc_f)
    yc_b, sc_b = ssd(flip(xc), flip(dtc[..., 1, :]), a[1], flip(bc), flip(cc), init)
    yl_b, _ = ssd(flip(xl), flip(dtl[..., 1, :]), a[1], flip(bl), flip(cl), sc_b)
    dskip = lp['ssm_d'].astype(jnp.float32)[:, None]

    def finish(yf, yb_rev, xs, z_):
        y = yf + flip(yb_rev) + dskip * xs.astype(jnp.float32)
        y = y.reshape(y.shape[:2] + (SSM_INNER,)).astype(z_.dtype) * jax.nn.silu(z_)
        return rms_norm(y, lp['ssm_norm'])

    y_lat = finish(yl_f, yl_b, xl, z)
    y_ctx = finish(yc_f, yc_b, xc, zc) if with_ctx else None
    return y_lat, y_ctx


def merge(ys, gate_pre, lp):
    gates = jax.nn.sigmoid(gate_pre + lp['b_gate']).reshape(gate_pre.shape[:-1] + (N_BRANCH, D_MODEL))
    yb = jnp.stack(ys, axis=-2)
    branch = jnp.einsum('...kw,kwd->...kd', yb, lp['w_branch'])
    return jnp.sum(gates * branch, axis=-2) @ lp['w_out']


def token_mix(h, hc, lp, cos, sin, with_ctx):
    offs = np.cumsum(IN_SIZES)[:-1].tolist()
    aq, ak, av, bq, bk, bv, cq, ck, cv, z, xbc, dt, gl = jnp.split(h @ lp['w_in'], offs, axis=-1)
    aqc, akc, avc, bqc, bkc, bvc, cqc, ckc, cvc, zc, xbcc, dtc, gc = jnp.split(hc @ lp['w_in'], offs, axis=-1)
    hs = split_heads
    rope = lambda t: apply_rope(t, cos, sin)
    qn = lambda t: rms_norm(hs(t), lp['qk_norm_q'])
    kn = lambda t: rms_norm(hs(t), lp['qk_norm_k'])
    akc_h, avc_h = hs(akc), hs(avc)
    bkc_h, bvc_h = hs(bkc), hs(bvc)
    ckc_h, cvc_h = kn(ckc), hs(cvc)
    ya = window_attention(rope(hs(aq)), rope(hs(ak)), hs(av), akc_h, avc_h, lp['attn_sink'])
    yb = neighborhood_attention(hs(bq), hs(bk), hs(bv), bkc_h, bvc_h, lp['na_rpb'])
    yc = dense_block_attention(rope(qn(cq)), rope(kn(ck)), hs(cv), ckc_h, cvc_h)
    yd, ydc = ssm_mixer(z, xbc, dt, zc, xbcc, dtc, lp, with_ctx)
    y_lat = merge([ya, yb, yc, yd], gl, lp)
    if not with_ctx:
        return y_lat, None
    yac = context_attention(hs(aqc), akc_h, avc_h, lp['attn_sink'])
    ybc = context_attention(hs(bqc), bkc_h, bvc_h, None)
    ycc = context_attention(qn(cqc), ckc_h, cvc_h, None)
    y_ctx = merge([yac, ybc, ycc, ydc], gc, lp)
    return y_lat, y_ctx


def layer(x, xc, c_act, cc_act, lp, cos, sin, with_ctx):
    mod = (c_act @ lp['w_mod'] + lp['b_mod']).reshape(c_act.shape[0], 1, 9, D_MODEL)
    modc = (cc_act @ lp['w_mod'] + lp['b_mod']).reshape(9, D_MODEL)
    m = lambda i: mod[:, :, i]
    mc = lambda i: modc[i]
    ada = lambda t, g, shift, scale: rms_norm(t, g) * (1 + scale) + shift
    ffn = lambda t, pre: swiglu(t, lp[pre + '_w_gate'], lp[pre + '_w_up'], lp[pre + '_w_down'])
    x = x + 0.5 * m(2) * ffn(ada(x, lp['norm_ffn1'], m(0), m(1)), 'ffn1')
    xc = xc + 0.5 * mc(2) * ffn(ada(xc, lp['norm_ffn1'], mc(0), mc(1)), 'ffn1')
    y, yc = token_mix(ada(x, lp['norm_mix'], m(3), m(4)), ada(xc, lp['norm_mix'], mc(3), mc(4)),
                      lp, cos, sin, with_ctx)
    x = x + m(5) * y
    x = x + 0.5 * m(8) * ffn(ada(x, lp['norm_ffn2'], m(6), m(7)), 'ffn2')
    if with_ctx:
        xc = xc + mc(5) * yc
        xc = xc + 0.5 * mc(8) * ffn(ada(xc, lp['norm_ffn2'], mc(6), mc(7)), 'ffn2')
    return x, xc


def setup_inputs(seed: int = 0) -> dict:
    key = jax.random.key(seed)
    k = jax.random.split(key, 32)
    f32 = jnp.float32
    D = D_MODEL
    L = DEPTH
    n_in = sum(IN_SIZES)
    nrm = lambda kk, shape, scale: jax.random.normal(kk, shape, f32) * scale
    gain = lambda kk, shape: 1.0 + 0.05 * jax.random.normal(kk, shape, f32)
    dt0 = jnp.exp(jax.random.uniform(k[19], (L, 2, SSM_HEADS), f32, math.log(1e-3), math.log(1e-1)))
    return {
        'x': nrm(k[0], (BATCH, SEQ, D), 1.0),
        'c': nrm(k[1], (BATCH, D), 1.0),
        'ctx': nrm(k[2], (BATCH, CTX_LEN, D), 1.0),
        'c_ctx': nrm(k[3], (D,), 1.0),
        'w_mod': nrm(k[4], (L, D, 9 * D), 0.5 * D ** -0.5),
        'b_mod': nrm(k[5], (L, 9 * D), 0.02),
        'norm_ffn1': gain(k[6], (L, D)),
        'ffn1_w_gate': nrm(k[7], (L, D, D_FF), D ** -0.5),
        'ffn1_w_up': nrm(k[8], (L, D, D_FF), D ** -0.5),
        'ffn1_w_down': nrm(k[9], (L, D_FF, D), D_FF ** -0.5),
        'norm_mix': gain(k[10], (L, D)),
        'w_in': nrm(k[11], (L, D, n_in), D ** -0.5),
        'b_gate': nrm(k[12], (L, N_BRANCH * D), 0.02),
        'attn_sink': nrm(k[13], (L, WA_Q_HEADS), 0.5),
        'na_rpb': nrm(k[14], (L, NA_HEADS, 2 * NA_ROWS - 1, 2 * NA_COLS - 1), 0.1),
        'qk_norm_q': gain(k[15], (L, HEAD_DIM)),
        'qk_norm_k': gain(k[16], (L, HEAD_DIM)),
        'ssm_conv_w': nrm(k[17], (L, SSM_CONV, SSM_CONV_CH), SSM_CONV ** -0.5),
        'ssm_conv_b': nrm(k[18], (L, SSM_CONV_CH), 0.02),
        'ssm_dt_bias': dt0 + jnp.log(-jnp.expm1(-dt0)),
        'ssm_a_log': jnp.log(jax.random.uniform(k[20], (L, 2, SSM_HEADS), f32, 1.0, 16.0)),
        'ssm_d': 1.0 + nrm(k[21], (L, SSM_HEADS), 0.1),
        'ssm_norm': gain(k[22], (L, SSM_INNER)),
        'w_branch': nrm(k[23], (L, N_BRANCH, BRANCH_W, D), BRANCH_W ** -0.5),
        'w_out': nrm(k[24], (L, D, D), D ** -0.5),
        'norm_ffn2': gain(k[25], (L, D)),
        'ffn2_w_gate': nrm(k[26], (L, D, D_FF), D ** -0.5),
        'ffn2_w_up': nrm(k[27], (L, D, D_FF), D ** -0.5),
        'ffn2_w_down': nrm(k[28], (L, D_FF, D), D_FF ** -0.5),
        'final_norm': gain(k[29], (D,)),
    }


def reference(x, c, ctx, c_ctx, w_mod, b_mod, norm_ffn1, ffn1_w_gate, ffn1_w_up, ffn1_w_down,
              norm_mix, w_in, b_gate, attn_sink, na_rpb, qk_norm_q, qk_norm_k,
              ssm_conv_w, ssm_conv_b, ssm_dt_bias, ssm_a_log, ssm_d, ssm_norm,
              w_branch, w_out, norm_ffn2, ffn2_w_gate, ffn2_w_up, ffn2_w_down, final_norm):
    cos, sin = rope_tables(x.shape[1])
    c_act = jax.nn.silu(c)
    cc_act = jax.nn.silu(c_ctx)
    xc = ctx
    for l in range(DEPTH):
        lp = {
            'w_mod': w_mod[l], 'b_mod': b_mod[l],
            'norm_ffn1': norm_ffn1[l], 'ffn1_w_gate': ffn1_w_gate[l], 'ffn1_w_up': ffn1_w_up[l],
            'ffn1_w_down': ffn1_w_down[l],
            'norm_mix': norm_mix[l], 'w_in': w_in[l], 'b_gate': b_gate[l],
            'attn_sink': attn_sink[l], 'na_rpb': na_rpb[l],
            'qk_norm_q': qk_norm_q[l], 'qk_norm_k': qk_norm_k[l],
            'ssm_conv_w': ssm_conv_w[l], 'ssm_conv_b': ssm_conv_b[l], 'ssm_dt_bias': ssm_dt_bias[l],
            'ssm_a_log': ssm_a_log[l], 'ssm_d': ssm_d[l], 'ssm_norm': ssm_norm[l],
            'w_branch': w_branch[l], 'w_out': w_out[l],
            'norm_ffn2': norm_ffn2[l], 'ffn2_w_gate': ffn2_w_gate[l], 'ffn2_w_up': ffn2_w_up[l],
            'ffn2_w_down': ffn2_w_down[l],
        }
        x, xc = layer(x, xc, c_act, cc_act, lp, cos, sin, l < DEPTH - 1)
    return rms_norm(x, final_norm)
```

```cpp
#define WGM_IN 8
#define WGM_DN 2
#include <hip/hip_runtime.h>
#include <hip/hip_cooperative_groups.h>
#include <cstdio>
#include <cstdint>
namespace cg = cooperative_groups;

#define PG8_LAS __attribute__((address_space(3)))
typedef unsigned short bf16_t;
typedef short bf16x8 __attribute__((ext_vector_type(8)));
typedef short bf16x4 __attribute__((ext_vector_type(4)));
typedef float f32x4 __attribute__((ext_vector_type(4)));
typedef unsigned u32x4 __attribute__((ext_vector_type(4)));
constexpr int BM = 256, BK = 64, HALF = 128, HTB = HALF * BK * 2, NXCD = 8;
#ifndef WGM_GU
#define WGM_GU 4
#endif
#ifndef WGM_DN
#define WGM_DN 4
#endif
#ifndef WGM_OT
#define WGM_OT 4
#endif
#ifndef WGM_IN
#define WGM_IN 4
#endif

constexpr int DM = 1024, NBATCH = 8, SEQ = 2048, CTXL = 256, DFF = 2816, DEPTH = 4, NIN = 6920;
constexpr int ML = NBATCH * SEQ, MC = NBATCH * CTXL, MT = ML + MC;
constexpr int P1W = 6144;
constexpr float EPS = 1e-6f;
constexpr float LOG2E = 1.4426950408889634f;
constexpr int LDS_BYTES = 147456;

constexpr size_t SZ_WGU = (size_t)5632 * 1024 * 2, SZ_WD = (size_t)1024 * 2816 * 2, SZ_WIN = (size_t)7168 * 1024 * 2, SZ_WBR = (size_t)4 * 1024 * 256 * 2, SZ_WO = (size_t)1024 * 1024 * 2;
constexpr size_t OFF_WGU1 = 0, OFF_WD1 = OFF_WGU1 + SZ_WGU, OFF_WIN = OFF_WD1 + SZ_WD, OFF_WBR = OFF_WIN + SZ_WIN, OFF_WO = OFF_WBR + SZ_WBR,
                 OFF_WGU2 = OFF_WO + SZ_WO, OFF_WD2 = OFF_WGU2 + SZ_WGU, OFF_X = OFF_WD2 + SZ_WD;
constexpr size_t OFF_H = OFF_X + (size_t)MT * 1024 * 4, OFF_BIG = OFF_H + (size_t)MT * 1024 * 2, OFF_PT = OFF_BIG + (size_t)MT * P1W * 2,
                 OFF_BC = OFF_PT + (size_t)1024 * MT * 2, OFF_XBT = OFF_BC + (size_t)MT * 512 * 2, OFF_ST = OFF_XBT + (size_t)512 * MT * 2,
                 OFF_Y = OFF_ST + (size_t)NBATCH * 18 * 8 * 8192 * 4, OFF_MOD = OFF_Y + (size_t)MT * 1024 * 2, OFF_DT = OFF_MOD + (size_t)4 * 9 * 9216 * 4,
                 OFF_CUM = OFF_DT + (size_t)MT * 8 * 4, OFF_TOT = OFF_CUM + (size_t)MT * 8 * 4, OFF_BAR = OFF_TOT + (size_t)NBATCH * 18 * 8 * 4, OFF_SIN = OFF_BAR + 16384, OFF_ROPE = OFF_SIN + (size_t)NBATCH * 18 * 8 * 8192 * 2, WS_END = OFF_ROPE + (size_t)2048 * 64 * 4;
constexpr size_t OFF_G = OFF_PT;

__host__ __device__ __forceinline__ int lds_byte(int r, int c) { const int st = (r >> 4) * 2 + (c >> 5), rr = r & 15, cc = c & 31, ob = rr * 64 + cc * 2; return st * 1024 + (ob ^ (((ob >> 9) & 1) << 5)); }
__host__ __device__ __forceinline__ void stage_rc(int b, int& R, int& C) { const int st = b / 1024, sb = b % 1024, swz = sb ^ (((sb >> 9) & 1) << 5); R = (st >> 1) * 16 + swz / 64; C = (st & 1) * 32 + (swz % 64) / 2; }
__host__ __device__ __forceinline__ int perm32(int rho) { const int n = rho >> 4, i = rho & 15; return 8 * (i >> 2) + 4 * n + (i & 3); }

struct Unit { int pm, pn, k0, nk, split; };
struct Gemm { const bf16_t* A; const bf16_t* Bt; const bf16_t* A2; const bf16_t* Bt2; int M, N, K; };

struct StaticOrder {
    int nM, nN, nwg, G, c, KT, nM2, nN2, nwg2, wgm;
    __host__ __device__ __forceinline__ void init(int M, int N, int K, int G_, int c_, int M2, int N2) {
        nM = M / BM; nN = N / BM; nwg = nM * nN; G = G_; c = c_; KT = K / BK; nM2 = M2 / BM; nN2 = N2 / BM; nwg2 = nM2 * nN2;
        wgm = N == 5632 ? WGM_GU : (K == DFF ? WGM_DN : (N == 6144 ? WGM_IN : WGM_OT));
    }
    __host__ __device__ __forceinline__ static void tile(int wgid, int nM_, int nN_, int nwg_, int WGM, Unit& u) {
        { const int q = nwg_ / NXCD, r = nwg_ % NXCD, xcd = wgid % NXCD, off = wgid / NXCD; wgid = (xcd < r ? xcd * (q + 1) : r * (q + 1) + (xcd - r) * q) + off; }
        const int nig = WGM * nN_, gid = wgid / nig, fm = gid * WGM, gsz = (nM_ - fm) < WGM ? (nM_ - fm) : WGM;
        u.pm = fm + ((wgid % nig) % gsz); u.pn = (wgid % nig) / gsz;
    }
    __host__ __device__ __forceinline__ bool next(int i, Unit& u) const {
        const long L = (long)i * G + c;
        u.k0 = 0; u.nk = KT;
        if (L < nwg) { tile((int)L, nM, nN, nwg, wgm, u); u.split = 0; return true; }
        if (L - nwg < nwg2) { tile((int)(L - nwg), nM2, nN2, nwg2, wgm, u); u.split = 1; return true; }
        return false;
    }
    __device__ __forceinline__ void a_ready(const Unit&) const {}
    __device__ __forceinline__ void done(const Unit&) const {}
};

__device__ __forceinline__ int opq_i(int v) { asm volatile("" : "+v"(v)); return __builtin_amdgcn_readfirstlane(v); }
template <class T> __device__ __forceinline__ T* opq_p(T* ptr) {
    unsigned long long a = (unsigned long long)ptr; unsigned lo = (unsigned)a, hi = (unsigned)(a >> 32);
    asm volatile("" : "+v"(lo), "+v"(hi));
    lo = (unsigned)__builtin_amdgcn_readfirstlane((int)lo); hi = (unsigned)__builtin_amdgcn_readfirstlane((int)hi);
    return (T*)(((unsigned long long)hi << 32) | lo);
}
__device__ __forceinline__ int tid_opaque() { int t = threadIdx.x; asm volatile("" : "+v"(t)); return t; }
__device__ __forceinline__ int bid_opaque() { return opq_i((int)blockIdx.x); }
#define TIDX tid_opaque()
#define BIDX bid_opaque()
__device__ __forceinline__ float bf2f(bf16_t v) { return __uint_as_float(((unsigned)v) << 16); }
__device__ __forceinline__ unsigned pk2(float lo, float hi);
__device__ __forceinline__ bf16_t f2bf(float x) { return (bf16_t)(pk2(x, x) & 0xffffu); }
typedef float f32x2v __attribute__((ext_vector_type(2)));
typedef __bf16 bf16x2v __attribute__((ext_vector_type(2)));
__device__ __forceinline__ unsigned pk2(float lo, float hi) { const f32x2v v = {lo, hi}; const bf16x2v b = __builtin_convertvector(v, bf16x2v); return __builtin_bit_cast(unsigned, b); }
__device__ __forceinline__ float siluf(float x) { return x * __builtin_amdgcn_rcpf(1.f + __expf(-x)); }
__device__ __forceinline__ float sigmf(float x) { return __builtin_amdgcn_rcpf(1.f + __expf(-x)); }
__device__ __forceinline__ float ex2(float x) { return __builtin_amdgcn_exp2f(x); }

typedef unsigned u32x2 __attribute__((ext_vector_type(2)));
typedef __attribute__((address_space(1))) const u32x2 gc_uint2;
typedef __attribute__((address_space(1))) const f32x4 gc_float4;
typedef __attribute__((address_space(1))) f32x4 g_float4;
typedef __attribute__((address_space(1))) u32x2 g_uint2;
struct EpiStore {
    static constexpr bool PERM = false, AFTER_DRAIN = false;
    bf16_t* C; long ldc;
    __device__ __forceinline__ void operator()(const f32x4 (&acc)[2][2][4][2], const Unit& u, int wr, int wc, int fr, int fq) const {
#pragma unroll
        for (int ai = 0; ai < 2; ++ai)
#pragma unroll
            for (int m = 0; m < 4; ++m) {
                const long r = 256 * u.pm + 128 * ai + 64 * wr + 16 * m + fr;
#pragma unroll
                for (int bj = 0; bj < 2; ++bj)
#pragma unroll
                    for (int n = 0; n < 2; ++n) {
                        const int c = 256 * u.pn + 128 * bj + 32 * wc + 16 * n + 4 * fq;
                        const f32x4 v = acc[ai][bj][m][n];
                        u32x2 o; o.x = pk2(v[0], v[1]); o.y = pk2(v[2], v[3]);
                        *(g_uint2*)(C + r * ldc + c) = o;
                    }
            }
    }
};
struct EpiGateUp {
    static constexpr bool PERM = false, AFTER_DRAIN = false;
    bf16_t* C;
    __device__ __forceinline__ void operator()(const f32x4 (&acc)[2][2][4][2], const Unit& u, int wr, int wc, int fr, int fq) const {
#pragma unroll
        for (int ai = 0; ai < 2; ++ai)
#pragma unroll
            for (int m = 0; m < 4; ++m) {
                const long r = 256 * u.pm + 128 * ai + 64 * wr + 16 * m + fr;
#pragma unroll
                for (int n = 0; n < 2; ++n) {
                    const int c = 128 * u.pn + 32 * wc + 16 * n + 4 * fq;
                    const f32x4 g = acc[ai][0][m][n], up = acc[ai][1][m][n];
                    u32x2 o; o.x = pk2(siluf(g[0]) * up[0], siluf(g[1]) * up[1]); o.y = pk2(siluf(g[2]) * up[2], siluf(g[3]) * up[3]);
                    *(g_uint2*)(C + r * DFF + c) = o;
                }
            }
    }
};
struct EpiResid {
    static constexpr bool PERM = false, AFTER_DRAIN = false;
    float* X; const float* modl; int idx; float coef;
    __device__ __forceinline__ void operator()(const f32x4 (&acc)[2][2][4][2], const Unit& u, int wr, int wc, int fr, int fq) const {
        const int bi = u.pm < 64 ? (u.pm >> 3) : 8;
        const float* mv = modl + bi * 9216 + idx * 1024;
#pragma unroll
        for (int bj = 0; bj < 2; ++bj)
#pragma unroll
            for (int n = 0; n < 2; ++n) {
                const int c = 256 * u.pn + 128 * bj + 32 * wc + 16 * n + 4 * fq;
                f32x4 mm = *(gc_float4*)(mv + c);
                mm.x *= coef; mm.y *= coef; mm.z *= coef; mm.w *= coef;
                f32x4 xv[8];
#pragma unroll
                for (int ai = 0; ai < 2; ++ai)
#pragma unroll
                    for (int m = 0; m < 4; ++m) xv[ai * 4 + m] = *(gc_float4*)(X + (long)(256 * u.pm + 128 * ai + 64 * wr + 16 * m + fr) * 1024 + c);
#pragma unroll
                for (int ai = 0; ai < 2; ++ai)
#pragma unroll
                    for (int m = 0; m < 4; ++m) {
                        const f32x4 v = acc[ai][bj][m][n];
                        f32x4 x = xv[ai * 4 + m];
                        x.x += mm.x * v[0]; x.y += mm.y * v[1]; x.z += mm.z * v[2]; x.w += mm.w * v[3];
                        *(g_float4*)(X + (long)(256 * u.pm + 128 * ai + 64 * wr + 16 * m + fr) * 1024 + c) = x;
                    }
            }
    }
};
struct EpiBranch {
    static constexpr bool PERM = false, AFTER_DRAIN = false;
    const bf16_t* P1; const float* bg; bf16_t* Gb;
    __device__ __forceinline__ static float e_of(float x) { return fminf(__expf(-x), 1e20f); }
    __device__ __forceinline__ void hook(f32x4 (&acc)[2][2][4][2], const Unit& u, int wr, int wc, int fr, int fq, int kb) const {
        asm volatile("" : "+v"(fr), "+v"(fq));
#pragma unroll
        for (int bj = 0; bj < 2; ++bj)
#pragma unroll
            for (int n = 0; n < 2; ++n) {
                const int c = 256 * u.pn + 128 * bj + 32 * wc + 16 * n + 4 * fq;
                const f32x4 b0 = *(gc_float4*)(bg + kb * 1024 + c), b1 = *(gc_float4*)(bg + (kb + 1) * 1024 + c);
                u32x2 g0[8], g1[8];
#pragma unroll
                for (int ai = 0; ai < 2; ++ai)
#pragma unroll
                    for (int m = 0; m < 4; ++m) {
                        const bf16_t* gp = P1 + (long)(256 * u.pm + 128 * ai + 64 * wr + 16 * m + fr) * P1W + 2048 + kb * 1024 + c;
                        g0[ai * 4 + m] = *(gc_uint2*)gp; g1[ai * 4 + m] = *(gc_uint2*)(gp + 1024);
                    }
#pragma unroll
                for (int ai = 0; ai < 2; ++ai)
#pragma unroll
                    for (int m = 0; m < 4; ++m) {
                        const u32x2 ga = g0[ai * 4 + m], gb = g1[ai * 4 + m];
                        f32x4 v = acc[ai][bj][m][n];
                        v[0] *= (1.f + e_of(__uint_as_float(gb.x << 16) + b1.x)) * __builtin_amdgcn_rcpf(1.f + e_of(__uint_as_float(ga.x << 16) + b0.x));
                        v[1] *= (1.f + e_of(__uint_as_float(gb.x & 0xffff0000u) + b1.y)) * __builtin_amdgcn_rcpf(1.f + e_of(__uint_as_float(ga.x & 0xffff0000u) + b0.y));
                        v[2] *= (1.f + e_of(__uint_as_float(gb.y << 16) + b1.z)) * __builtin_amdgcn_rcpf(1.f + e_of(__uint_as_float(ga.y << 16) + b0.z));
                        v[3] *= (1.f + e_of(__uint_as_float(gb.y & 0xffff0000u) + b1.w)) * __builtin_amdgcn_rcpf(1.f + e_of(__uint_as_float(ga.y & 0xffff0000u) + b0.w));
                        acc[ai][bj][m][n] = v;
                    }
            }
    }
    __device__ __forceinline__ void operator()(const f32x4 (&acc)[2][2][4][2], const Unit& u, int wr, int wc, int fr, int fq) const {
#pragma unroll
        for (int bj = 0; bj < 2; ++bj)
#pragma unroll
            for (int n = 0; n < 2; ++n) {
                const int c = 256 * u.pn + 128 * bj + 32 * wc + 16 * n + 4 * fq;
                const f32x4 bb = *(gc_float4*)(bg + 3 * 1024 + c);
                u32x2 g3[8];
#pragma unroll
                for (int ai = 0; ai < 2; ++ai)
#pragma unroll
                    for (int m = 0; m < 4; ++m) g3[ai * 4 + m] = *(gc_uint2*)(P1 + (long)(256 * u.pm + 128 * ai + 64 * wr + 16 * m + fr) * P1W + 2048 + 3 * 1024 + c);
#pragma unroll
                for (int ai = 0; ai < 2; ++ai)
#pragma unroll
                    for (int m = 0; m < 4; ++m) {
                        const long r = 256 * u.pm + 128 * ai + 64 * wr + 16 * m + fr;
                        const f32x4 v = acc[ai][bj][m][n];
                        const u32x2 gp = g3[ai * 4 + m];
                        const float o0 = v[0] * __builtin_amdgcn_rcpf(1.f + e_of(__uint_as_float(gp.x << 16) + bb.x));
                        const float o1 = v[1] * __builtin_amdgcn_rcpf(1.f + e_of(__uint_as_float(gp.x & 0xffff0000u) + bb.y));
                        const float o2 = v[2] * __builtin_amdgcn_rcpf(1.f + e_of(__uint_as_float(gp.y << 16) + bb.z));
                        const float o3 = v[3] * __builtin_amdgcn_rcpf(1.f + e_of(__uint_as_float(gp.y & 0xffff0000u) + bb.w));
                        u32x2 ob; ob.x = pk2(o0, o1); ob.y = pk2(o2, o3); *(g_uint2*)(Gb + r * 1024 + c) = ob;
                    }
            }
    }
};

template <class Epi, class Sched, bool ALIGN_EPI = false, bool SP2 = false>
__device__ __forceinline__ void gemm_phase(PG8_LAS unsigned char* lds, const Gemm g, const Sched& S, const Epi& E) {
    int tid_ = threadIdx.x; asm volatile("" : "+v"(tid_));
    const int tid = tid_, wid = __builtin_amdgcn_readfirstlane(tid >> 6), lane = tid & 63, wr = wid >> 2, wc = wid & 3, fr = lane & 15, fq = lane >> 4;
    const int K = g.K;
    unsigned voffA[2], voffB[2];
#pragma unroll
    for (int i = 0; i < 2; ++i) { int R, C; stage_rc(tid * 16 + i * 8192, R, C); const int Rb = Epi::PERM ? ((R & ~31) + perm32(R & 31)) : R;
        voffA[i] = (unsigned)(R * K + C) * 2u; voffB[i] = (unsigned)(Rb * K + C) * 2u; }
    const size_t kstep = (size_t)(BK * 2);
    const size_t hstep = (size_t)HALF * K * 2;
    const size_t tstep = 2 * hstep;
    const unsigned ldsw = (unsigned)wid * 1024u;
    const int aoff = lds_byte(wr * 64 + fr, fq * 8), boff = lds_byte(wc * 32 + fr, fq * 8);
#define PG8_SA(b, h) (((b) * 2 + (h)) * HTB)
#define PG8_SB(b, h) ((4 + (b) * 2 + (h)) * HTB)
#define PG8_STAGE(bufoff, gbase, voff) do { _Pragma("unroll") for (int _i = 0; _i < 2; ++_i) \
        __builtin_amdgcn_global_load_lds((const unsigned*)((const char*)(gbase) + (voff)[_i]), (PG8_LAS unsigned*)(lds + (bufoff) + ldsw + _i * 8192), 16, 0, 0); } while (0)
#define PG8_LDA(dst, b, h) do { _Pragma("unroll") for (int m = 0; m < 4; ++m) _Pragma("unroll") for (int k = 0; k < 2; ++k) dst[m][k] = *(const PG8_LAS bf16x8*)(lds + PG8_SA(b, h) + aoff + m * 2048 + k * 1024); } while (0)
#define PG8_LDB(dst, b, h) do { _Pragma("unroll") for (int n = 0; n < 2; ++n) _Pragma("unroll") for (int k = 0; k < 2; ++k) dst[n][k] = *(const PG8_LAS bf16x8*)(lds + PG8_SB(b, h) + boff + n * 2048 + k * 1024); } while (0)
#define PG8_MMA(ai, bj, At, Bt) do { __builtin_amdgcn_s_setprio(1); _Pragma("unroll") for (int m = 0; m < 4; ++m) _Pragma("unroll") for (int n = 0; n < 2; ++n) _Pragma("unroll") for (int k = 0; k < 2; ++k) \
        acc[ai][bj][m][n] = __builtin_amdgcn_mfma_f32_16x16x32_bf16(Bt[n][k], At[m][k], acc[ai][bj][m][n], 0, 0, 0); __builtin_amdgcn_s_setprio(0); } while (0)
#define PG8_WAIT_V(n) asm volatile("s_waitcnt vmcnt(" #n ")" ::: "memory")
#define PG8_WAIT_L(n) asm volatile("s_waitcnt lgkmcnt(" #n ")" ::: "memory")
#define PG8_BAR __builtin_amdgcn_s_barrier()
#define PG8_SCHED __builtin_amdgcn_sched_barrier(0)
    Unit cur, nxt; int ui = 0;
    if (!S.next(0, cur)) return;
    f32x4 acc[2][2][4][2];
#pragma unroll
    for (int a = 0; a < 2; ++a)
#pragma unroll
        for (int b = 0; b < 2; ++b)
#pragma unroll
            for (int m = 0; m < 4; ++m)
#pragma unroll
                for (int n = 0; n < 2; ++n) acc[a][b][m][n] = (f32x4){0.f, 0.f, 0.f, 0.f};
    bf16x8 At[4][2], B0[2][2], B1[2][2];
    const char* cA = (const char*)(cur.split ? g.A2 : g.A) + (size_t)cur.pm * tstep + (size_t)cur.k0 * kstep; const char* cB = (const char*)(cur.split ? g.Bt2 : g.Bt) + (size_t)cur.pn * tstep + (size_t)cur.k0 * kstep;
    S.a_ready(cur);
    if constexpr (SP2) {
        PG8_STAGE(PG8_SB(0, 0), cB, voffB); PG8_STAGE(PG8_SB(0, 1), cB + hstep, voffB); PG8_STAGE(PG8_SA(0, 0), cA, voffA); PG8_STAGE(PG8_SA(0, 1), cA + hstep, voffA);
        if (wr == 1) PG8_BAR;
        PG8_WAIT_V(2); PG8_BAR;
        PG8_STAGE(PG8_SB(1, 0), cB + kstep, voffB); PG8_STAGE(PG8_SA(1, 0), cA + kstep, voffA); PG8_STAGE(PG8_SB(1, 1), cB + hstep + kstep, voffB);
        PG8_WAIT_V(6); PG8_BAR;
    } else {
        PG8_STAGE(PG8_SB(0, 0), cB, voffB); PG8_STAGE(PG8_SA(0, 0), cA, voffA); PG8_STAGE(PG8_SB(0, 1), cB + hstep, voffB); PG8_STAGE(PG8_SA(0, 1), cA + hstep, voffA);
        if (wr == 1) PG8_BAR;
        PG8_WAIT_V(4); PG8_BAR;
        PG8_STAGE(PG8_SB(1, 0), cB + kstep, voffB); PG8_STAGE(PG8_SA(1, 0), cA + kstep, voffA); PG8_STAGE(PG8_SB(1, 1), cB + hstep + kstep, voffB);
        PG8_WAIT_V(6); PG8_BAR;
    }
    for (;;) {
        const bool has_next = S.next(ui + 1, nxt);
        const char* nA = has_next ? (const char*)(nxt.split ? g.A2 : g.A) + (size_t)nxt.pm * tstep + (size_t)nxt.k0 * kstep : cA; const char* nB = has_next ? (const char*)(nxt.split ? g.Bt2 : g.Bt) + (size_t)nxt.pn * tstep + (size_t)nxt.k0 * kstep : cB;
        const int nt = cur.nk;
        for (int t = 0; t < nt; t += 2) {
            const bool last = (t == nt - 2);
            const char* a1 = cA + (size_t)(t + 1) * kstep;
            const char* a2 = last ? nA : cA + (size_t)(t + 2) * kstep; const char* b2 = last ? nB : cB + (size_t)(t + 2) * kstep;
            const char* a3 = a2 + kstep; const char* b3 = b2 + kstep;
            if (last && has_next) S.a_ready(nxt);
            if constexpr (SP2) {
            PG8_LDB(B0, 0, 0); PG8_LDB(B1, 0, 1); PG8_SCHED; PG8_LDA(At, 0, 0); PG8_STAGE(PG8_SA(1, 1), a1 + hstep, voffA);
            PG8_WAIT_V(8); PG8_WAIT_L(0); PG8_BAR; PG8_MMA(0, 0, At, B0); PG8_MMA(0, 1, At, B1); PG8_BAR; PG8_SCHED;
            PG8_LDA(At, 0, 1); PG8_STAGE(PG8_SB(0, 0), b2, voffB); PG8_STAGE(PG8_SB(0, 1), b2 + hstep, voffB); PG8_STAGE(PG8_SA(0, 0), a2, voffA);
            PG8_WAIT_V(8); PG8_WAIT_L(0); PG8_BAR; PG8_MMA(1, 0, At, B0); PG8_MMA(1, 1, At, B1); PG8_BAR; PG8_SCHED;
            PG8_LDB(B0, 1, 0); PG8_LDB(B1, 1, 1); PG8_SCHED; PG8_LDA(At, 1, 0); PG8_STAGE(PG8_SA(0, 1), a2 + hstep, voffA);
            PG8_WAIT_V(8); PG8_WAIT_L(0); PG8_BAR; PG8_MMA(0, 0, At, B0); PG8_MMA(0, 1, At, B1); PG8_BAR; PG8_SCHED;
            PG8_LDA(At, 1, 1); PG8_STAGE(PG8_SB(1, 0), b3, voffB); PG8_STAGE(PG8_SB(1, 1), b3 + hstep, voffB); PG8_STAGE(PG8_SA(1, 0), a3, voffA);
            PG8_WAIT_V(8); PG8_WAIT_L(0); PG8_BAR; PG8_MMA(1, 0, At, B0); PG8_MMA(1, 1, At, B1); PG8_BAR; PG8_SCHED;
            } else {
            PG8_LDB(B0, 0, 0); PG8_SCHED; PG8_LDA(At, 0, 0); PG8_STAGE(PG8_SA(1, 1), a1 + hstep, voffA);
            PG8_WAIT_L(8); PG8_BAR; PG8_WAIT_L(0); PG8_MMA(0, 0, At, B0); PG8_BAR; PG8_SCHED;
            PG8_LDB(B1, 0, 1); PG8_STAGE(PG8_SB(0, 0), b2, voffB);
            PG8_BAR; PG8_WAIT_L(0); PG8_MMA(0, 1, At, B1); PG8_BAR;
            PG8_LDA(At, 0, 1); PG8_STAGE(PG8_SA(0, 0), a2, voffA);
            PG8_BAR; PG8_WAIT_L(0); PG8_MMA(1, 0, At, B0); PG8_BAR; PG8_SCHED;
            PG8_STAGE(PG8_SB(0, 1), b2 + hstep, voffB);
            PG8_WAIT_V(6); PG8_BAR; PG8_MMA(1, 1, At, B1); PG8_BAR;
            PG8_LDB(B0, 1, 0); PG8_SCHED; PG8_LDA(At, 1, 0); PG8_STAGE(PG8_SA(0, 1), a2 + hstep, voffA);
            PG8_WAIT_L(8); PG8_BAR; PG8_WAIT_L(0); PG8_MMA(0, 0, At, B0); PG8_BAR; PG8_SCHED;
            PG8_LDB(B1, 1, 1); PG8_STAGE(PG8_SB(1, 0), b3, voffB);
            PG8_BAR; PG8_WAIT_L(0); PG8_MMA(0, 1, At, B1); PG8_BAR;
            PG8_LDA(At, 1, 1); PG8_STAGE(PG8_SA(1, 0), a3, voffA);
            PG8_BAR; PG8_WAIT_L(0); PG8_MMA(1, 0, At, B0); PG8_BAR; PG8_SCHED;
            PG8_STAGE(PG8_SB(1, 1), b3 + hstep, voffB);
            PG8_WAIT_V(6); PG8_BAR; PG8_MMA(1, 1, At, B1); PG8_BAR;
            }
            if (E.hook_on() && ((t + 2) & 3) == 0 && t + 2 < nt) E.hook(acc, cur, wr, wc, fr, fq, ((t + 2) >> 2) - 1);
        }
        if constexpr (ALIGN_EPI) { if (wr == 0) PG8_BAR; }
        if constexpr (!Epi::AFTER_DRAIN) { E(acc, cur, wr, wc, fr, fq); S.done(cur); }
        if (!has_next) break;
#pragma unroll
        for (int a = 0; a < 2; ++a)
#pragma unroll
            for (int b = 0; b < 2; ++b)
#pragma unroll
                for (int m = 0; m < 4; ++m)
#pragma unroll
                    for (int n = 0; n < 2; ++n) acc[a][b][m][n] = (f32x4){0.f, 0.f, 0.f, 0.f};
        cur = nxt; cA = nA; cB = nB; ++ui;
        if constexpr (ALIGN_EPI) { if (wr == 1) PG8_BAR; }
    }
    PG8_WAIT_V(0);
    if constexpr (!ALIGN_EPI) { if (wr == 0) PG8_BAR; }
    PG8_BAR;
    if constexpr (Epi::AFTER_DRAIN) { E.fused(acc, cur, wr, wc, fr, fq, lds, wid, lane); S.done(cur); }
#undef PG8_SA
#undef PG8_SB
#undef PG8_STAGE
#undef PG8_LDA
#undef PG8_LDB
#undef PG8_MMA
#undef PG8_WAIT_V
#undef PG8_WAIT_L
#undef PG8_BAR
#undef PG8_SCHED
}

#define MFMA32(a, b, c) __builtin_amdgcn_mfma_f32_16x16x32_bf16((a), (b), (c), 0, 0, 0)
#define MFMA16(a, b, c) __builtin_amdgcn_mfma_f32_16x16x16bf16_1k((a), (b), (c), 0, 0, 0)

struct Params { const float* in[30]; float* out; unsigned char* ws; };
__device__ __forceinline__ unsigned char* ws_load() { unsigned char* const* tab = (unsigned char* const*)opq_p((const void*)__builtin_amdgcn_kernarg_segment_ptr()); return opq_p(tab[31]); }
#define WSP(p) ws_load()
__device__ __forceinline__ const float* pin_load(int i) { const float* const* tab = (const float* const*)opq_p((const void*)__builtin_amdgcn_kernarg_segment_ptr()); return opq_p(tab[i]); }
#define PIN(p, i) pin_load(i)
enum { I_X = 0, I_C, I_CTX, I_CCTX, I_WMOD, I_BMOD, I_NFFN1, I_F1G, I_F1U, I_F1D, I_NMIX, I_WIN, I_BGATE, I_SINK, I_RPB, I_QNQ, I_QNK,
       I_CONVW, I_CONVB, I_DTB, I_ALOG, I_SSMD, I_SSMN, I_WBR, I_WOUT, I_NFFN2, I_F2G, I_F2U, I_F2D, I_FNORM };

__device__ __forceinline__ void win_map(int n, int& r1, int& r2) {
    r1 = -1; r2 = -1;
    if (n < 256) r1 = n;
    else if (n < 384) r1 = 256 + (n - 256);
    else if (n < 512) r2 = n - 384;
    else if (n < 768) r1 = 384 + (n - 512);
    else if (n < 1024) r1 = 640 + (n - 768);
    else if (n < 1280) r2 = 128 + (n - 1024);
    else if (n < 1536) r1 = 896 + (n - 1280);
    else if (n < 1664) r1 = 1152 + (n - 1536);
    else if (n < 1792) r2 = 384 + (n - 1664);
    else if (n < 2048) r1 = 1280 + (n - 1792);
    else if (n < 2304) r2 = 512 + (n - 2048);
    else if (n < 2560) { r1 = 1536 + (n - 2304); r2 = 768 + (n - 2304); }
    else if (n < 2816) r1 = 1792 + (n - 2560);
    else if (n < 2824) { }
    else r1 = 2048 + (n - 2824);
    if (r2 >= 0) r2 += 6144;
}
__device__ __forceinline__ void convert_tile4(const float* __restrict__ src, int N, int ntn, int tk, int tn0, int kind, bf16_t* __restrict__ dst, int ldd, PG8_LAS float* tile) {
    const int tid = TIDX;
    const int kk = tid >> 3, nn = (tid & 7) * 8, k0 = tk * 64;
    float4 va[4], vb[4]; bool okv[4];
#pragma unroll
    for (int j = 0; j < 4; ++j) {
        const int n0 = (tn0 + j) * 64;
        okv[j] = (tn0 + j < ntn) && (n0 + nn + 8 <= N);
        const float* sp = src + (size_t)(k0 + kk) * N + (okv[j] ? n0 + nn : 0);
        va[j] = *(const float4*)sp; vb[j] = *(const float4*)(sp + 4);
    }
#pragma unroll
    for (int j = 0; j < 4; ++j) if (!okv[j]) { va[j] = make_float4(0.f, 0.f, 0.f, 0.f); vb[j] = va[j]; }
#pragma unroll
    for (int j = 0; j < 4; ++j) {
        PG8_LAS float* t = tile + j * (64 * 65) + kk * 65 + nn;
        t[0] = va[j].x; t[1] = va[j].y; t[2] = va[j].z; t[3] = va[j].w; t[4] = vb[j].x; t[5] = vb[j].y; t[6] = vb[j].z; t[7] = vb[j].w;
    }
    __syncthreads();
    const int nr = tid >> 3, kc = (tid & 7) * 8;
#pragma unroll
    for (int j = 0; j < 4; ++j) {
        const int n = (tn0 + j) * 64 + nr;
        if (tn0 + j < ntn && n < N) {
            const PG8_LAS float* t = tile + j * (64 * 65) + nr;
            uint4 o;
            o.x = pk2(t[(kc + 0) * 65], t[(kc + 1) * 65]); o.y = pk2(t[(kc + 2) * 65], t[(kc + 3) * 65]);
            o.z = pk2(t[(kc + 4) * 65], t[(kc + 5) * 65]); o.w = pk2(t[(kc + 6) * 65], t[(kc + 7) * 65]);
            int r1 = -1, r2 = -1;
            if (kind == 0) r1 = n; else if (kind == 1) r1 = (n >> 7) * 256 + (n & 127); else if (kind == 2) r1 = (n >> 7) * 256 + 128 + (n & 127); else win_map(n, r1, r2);
            if (r1 >= 0) *(uint4*)(dst + (size_t)r1 * ldd + k0 + kc) = o;
            if (r2 >= 0) *(uint4*)(dst + (size_t)r2 * ldd + k0 + kc) = o;
        }
    }
    __syncthreads();
}
__device__ __forceinline__ void convert_layer(const Params& p, int l, PG8_LAS float* tile, int lo = 0, int hi = 1632, int c0 = 0) {
    unsigned char* ws = WSP(p);
    const int bid = BIDX;
    if (bid < c0) return;
    for (int it0 = lo + (bid - c0); it0 < hi; it0 += (int)gridDim.x - c0) {
        int it = it0;
        if (it < 176) convert_tile4(PIN(p, I_F1G) + (size_t)l * 1024 * 2816, 2816, 44, it / 11, (it % 11) * 4, 1, (bf16_t*)(ws + OFF_WGU1), 1024, tile);
        else if (it < 352) { it -= 176; convert_tile4(PIN(p, I_F1U) + (size_t)l * 1024 * 2816, 2816, 44, it / 11, (it % 11) * 4, 2, (bf16_t*)(ws + OFF_WGU1), 1024, tile); }
        else if (it < 528) { it -= 352; convert_tile4(PIN(p, I_F1D) + (size_t)l * 2816 * 1024, 1024, 16, it >> 2, (it & 3) * 4, 0, (bf16_t*)(ws + OFF_WD1), 2816, tile); }
        else if (it < 976) { it -= 528; convert_tile4(PIN(p, I_WIN) + (size_t)l * 1024 * NIN, NIN, 109, it / 28, (it % 28) * 4, 3, (bf16_t*)(ws + OFF_WIN), 1024, tile); }
        else if (it < 1040) { it -= 976; const int kb = it >> 4, r = it & 15; convert_tile4(PIN(p, I_WBR) + (size_t)(l * 4 + kb) * 256 * 1024, 1024, 16, r >> 2, (r & 3) * 4, 0, (bf16_t*)(ws + OFF_WBR) + (size_t)kb * 256, 1024, tile); }
        else if (it < 1104) { it -= 1040; convert_tile4(PIN(p, I_WOUT) + (size_t)l * 1024 * 1024, 1024, 16, it >> 2, (it & 3) * 4, 0, (bf16_t*)(ws + OFF_WO), 1024, tile); }
        else if (it < 1280) { it -= 1104; convert_tile4(PIN(p, I_F2G) + (size_t)l * 1024 * 2816, 2816, 44, it / 11, (it % 11) * 4, 1, (bf16_t*)(ws + OFF_WGU2), 1024, tile); }
        else if (it < 1456) { it -= 1280; convert_tile4(PIN(p, I_F2U) + (size_t)l * 1024 * 2816, 2816, 44, it / 11, (it % 11) * 4, 2, (bf16_t*)(ws + OFF_WGU2), 1024, tile); }
        else { it -= 1456; convert_tile4(PIN(p, I_F2D) + (size_t)l * 2816 * 1024, 1024, 16, it >> 2, (it & 3) * 4, 0, (bf16_t*)(ws + OFF_WD2), 2816, tile); }
    }
}

__device__ __forceinline__ void phase_mod(const Params& p, PG8_LAS float* lf) {
    const int tid = TIDX;
    PG8_LAS float* sA = lf;
    PG8_LAS float* red = lf + 9216;
    for (int i = tid; i < 9216; i += 512) { const int bi = i >> 10, k = i & 1023; const float v = bi < 8 ? PIN(p, I_C)[bi * 1024 + k] : PIN(p, I_CCTX)[k]; sA[i] = siluf(v); }
    __syncthreads();
    float* MOD = (float*)(WSP(p) + OFF_MOD);
    for (int it = BIDX; it < 4 * 144; it += gridDim.x) {
        const int l = it / 144, cb = it % 144, cl = tid & 63, kp = tid >> 6, col = cb * 64 + cl;
        const float* w = PIN(p, I_WMOD) + ((size_t)l * 1024 + kp * 128) * 9216 + col;
        float a0 = 0, a1 = 0, a2 = 0, a3 = 0, a4 = 0, a5 = 0, a6 = 0, a7 = 0, a8 = 0;
        for (int k = 0; k < 128; ++k) {
            const float wv = w[(size_t)k * 9216]; const int kk = kp * 128 + k;
            a0 += sA[kk] * wv; a1 += sA[1024 + kk] * wv; a2 += sA[2048 + kk] * wv; a3 += sA[3072 + kk] * wv; a4 += sA[4096 + kk] * wv;
            a5 += sA[5120 + kk] * wv; a6 += sA[6144 + kk] * wv; a7 += sA[7168 + kk] * wv; a8 += sA[8192 + kk] * wv;
        }
        red[(kp * 9 + 0) * 64 + cl] = a0; red[(kp * 9 + 1) * 64 + cl] = a1; red[(kp * 9 + 2) * 64 + cl] = a2; red[(kp * 9 + 3) * 64 + cl] = a3; red[(kp * 9 + 4) * 64 + cl] = a4;
        red[(kp * 9 + 5) * 64 + cl] = a5; red[(kp * 9 + 6) * 64 + cl] = a6; red[(kp * 9 + 7) * 64 + cl] = a7; red[(kp * 9 + 8) * 64 + cl] = a8;
        __syncthreads();
        for (int o = tid; o < 576; o += 512) {
            const int bi = o >> 6, cc = o & 63; float s = 0.f;
#pragma unroll
            for (int q = 0; q < 8; ++q) s += red[(q * 9 + bi) * 64 + cc];
            MOD[(size_t)(l * 9 + bi) * 9216 + cb * 64 + cc] = s + PIN(p, I_BMOD)[l * 9216 + cb * 64 + cc];
        }
        __syncthreads();
    }
}
__device__ __forceinline__ void phase_copy_x(const Params& p) {
    float4* X = (float4*)(WSP(p) + OFF_X);
    const float4* xs = (const float4*)PIN(p, I_X); const float4* cs = (const float4*)PIN(p, I_CTX);
    const size_t nl = (size_t)ML * 256, nc = (size_t)MC * 256, stride = (size_t)gridDim.x * 512;
    for (size_t i = (size_t)BIDX * 512 + TIDX; i < nl + nc; i += stride) X[i] = i < nl ? xs[i] : cs[i - nl];
}

template <bool WITH_DT>
__device__ __forceinline__ void phase_ada(const Params& p, const float* __restrict__ gain, int l, int ishift, int iscale, PG8_LAS float* lf) {
    unsigned char* ws = WSP(p);
    const float* __restrict__ X = (const float*)(ws + OFF_X); bf16_t* __restrict__ H = (bf16_t*)(ws + OFF_H);
    const float* __restrict__ modl = (const float*)(ws + OFF_MOD) + (size_t)l * 9 * 9216;
    const int tid = TIDX, lane = tid & 63, gw = BIDX * 8 + (tid >> 6), nw = gridDim.x * 8;
    if constexpr (WITH_DT) {
        const float* wdt = PIN(p, I_WIN) + (size_t)l * 1024 * NIN + 2816;
        for (int i = tid; i < 8192; i += 512) { const int k = i >> 3, j = i & 7; lf[j * 1024 + k] = wdt[(size_t)k * NIN + j]; }
        __syncthreads();
    }
    float4 gv[4];
#pragma unroll
    for (int i = 0; i < 4; ++i) gv[i] = *(const float4*)(gain + i * 256 + lane * 4);
    for (int row0 = gw; row0 < MT / 2; row0 += nw) {
        float4 v[2][4], sv[2][4], hv[2][4]; float ss[2] = {0.f, 0.f};
#pragma unroll
        for (int q = 0; q < 2; ++q) {
            const int row = row0 + q * (MT / 2);
            const int bi = row < ML ? (row >> 11) : 8;
            const float* xr = X + (size_t)row * 1024;
            const float* sh = modl + bi * 9216 + ishift * 1024; const float* sc = modl + bi * 9216 + iscale * 1024;
#pragma unroll
            for (int i = 0; i < 4; ++i) { v[q][i] = *(const float4*)(xr + i * 256 + lane * 4); sv[q][i] = *(const float4*)(sc + i * 256 + lane * 4); hv[q][i] = *(const float4*)(sh + i * 256 + lane * 4); }
        }
#pragma unroll
        for (int q = 0; q < 2; ++q) {
#pragma unroll
            for (int i = 0; i < 4; ++i) ss[q] += v[q][i].x * v[q][i].x + v[q][i].y * v[q][i].y + v[q][i].z * v[q][i].z + v[q][i].w * v[q][i].w;
        }
#pragma unroll
        for (int o = 1; o < 64; o <<= 1) { ss[0] += __shfl_xor(ss[0], o); ss[1] += __shfl_xor(ss[1], o); }
#pragma unroll
        for (int q = 0; q < 2; ++q) {
            const int row = row0 + q * (MT / 2);
            const float rstd = rsqrtf(ss[q] * (1.f / 1024.f) + EPS);
            float dta[8];
            if constexpr (WITH_DT) {
#pragma unroll
                for (int j = 0; j < 8; ++j) dta[j] = 0.f;
            }
#pragma unroll
            for (int i = 0; i < 4; ++i) {
                const int c = i * 256 + lane * 4;
                const float4 g = gv[i], s = sv[q][i], h = hv[q][i];
                const float o0 = v[q][i].x * rstd * g.x * (1.f + s.x) + h.x, o1 = v[q][i].y * rstd * g.y * (1.f + s.y) + h.y;
                const float o2 = v[q][i].z * rstd * g.z * (1.f + s.z) + h.z, o3 = v[q][i].w * rstd * g.w * (1.f + s.w) + h.w;
                uint2 o; o.x = pk2(o0, o1); o.y = pk2(o2, o3);
                *(uint2*)(H + (size_t)row * 1024 + c) = o;
                if constexpr (WITH_DT) {
#pragma unroll
                    for (int j = 0; j < 8; ++j) { const f32x4 w4 = *(const PG8_LAS f32x4*)(lf + j * 1024 + c); dta[j] += o0 * w4[0] + o1 * w4[1] + o2 * w4[2] + o3 * w4[3]; }
                }
            }
            if constexpr (WITH_DT) {
#pragma unroll
                for (int j = 0; j < 8; ++j) {
#pragma unroll
                    for (int o = 1; o < 64; o <<= 1) dta[j] += __shfl_xor(dta[j], o);
                }
                float mine = dta[0];
#pragma unroll
                for (int j = 1; j < 8; ++j) mine = lane == j ? dta[j] : mine;
                if (lane < 8) {
                    const float xx = mine + PIN(p, I_DTB)[l * 8 + lane];
                    const float e = __expf(-fabsf(xx)); const float lp = e < 0.02f ? e * (1.f - e * (0.5f - e * (1.f / 3.f))) : __logf(1.f + e);
                    ((float*)(ws + OFF_DT))[(size_t)row * 8 + lane] = fmaxf(xx, 0.f) + lp;
                }
            }
        }
    }
    if constexpr (WITH_DT) __syncthreads();
}
__device__ __forceinline__ void phase_final(const Params& p) {
    const float* X = (const float*)(WSP(p) + OFF_X); const float* gain = PIN(p, I_FNORM); float* outp = (float*)pin_load(30);
    const int lane = TIDX & 63, gw = BIDX * 8 + (TIDX >> 6), nw = gridDim.x * 8;
    for (int row = gw; row < ML; row += nw) {
        const float* xr = X + (size_t)row * 1024;
        float4 v[4]; float ss = 0.f;
#pragma unroll
        for (int i = 0; i < 4; ++i) { v[i] = *(const float4*)(xr + i * 256 + lane * 4); ss += v[i].x * v[i].x + v[i].y * v[i].y + v[i].z * v[i].z + v[i].w * v[i].w; }
#pragma unroll
        for (int o = 1; o < 64; o <<= 1) ss += __shfl_xor(ss, o);
        const float rstd = rsqrtf(ss * (1.f / 1024.f) + EPS);
#pragma unroll
        for (int i = 0; i < 4; ++i) {
            const int c = i * 256 + lane * 4; const float4 g = *(const float4*)(gain + c);
            float4 o; o.x = v[i].x * rstd * g.x; o.y = v[i].y * rstd * g.y; o.z = v[i].z * rstd * g.z; o.w = v[i].w * rstd * g.w;
            *(float4*)(outp + (size_t)row * 1024 + c) = o;
        }
    }
}

__device__ __forceinline__ void phase_rope_table() {
    float* T = (float*)(WSP(p) + OFF_ROPE);
    const size_t nthr = (size_t)gridDim.x * 512;
    for (size_t idx = (size_t)BIDX * 512 + TIDX; idx < (size_t)2048 * 32; idx += nthr) {
        const int pos = (int)(idx >> 5), k = (int)(idx & 31), axis = k >> 4, i = k & 15;
        const float inv = exp2f(-(float)i * (13.287712379549449f / 16.f));
        const float ang = (float)(axis == 0 ? (pos >> 6) : (pos & 63)) * inv;
        T[(size_t)pos * 64 + k] = cosf(ang); T[(size_t)pos * 64 + 32 + k] = sinf(ang);
    }
}
__device__ __forceinline__ void phase_prep(const Params& p, int l) {
    unsigned char* ws = WSP(p);
    bf16_t* __restrict__ P1 = (bf16_t*)(ws + OFF_BIG); const bf16_t* __restrict__ PT = (const bf16_t*)(ws + OFF_PT);
    bf16_t* __restrict__ BC = (bf16_t*)(ws + OFF_BC); bf16_t* __restrict__ XBT = (bf16_t*)(ws + OFF_XBT);
    const float* __restrict__ ROPE = (const float*)(ws + OFF_ROPE);
    const int tid = TIDX;
    const size_t gtid = (size_t)BIDX * 512 + tid, nthr = (size_t)gridDim.x * 512;
    {
        const float* __restrict__ gq = PIN(p, I_QNQ) + l * 64; const float* __restrict__ gk = PIN(p, I_QNK) + l * 64;
        for (size_t pr = gtid; pr < (size_t)MT * 12; pr += nthr) {
            const int row = (int)(pr / 12), slot = (int)(pr % 12);
            const bool lat = row < ML;
            if (!lat && slot < 6) continue;
            int col; const float* g = nullptr;
            if (slot < 4) col = slot * 64; else if (slot < 6) col = 256 + (slot - 4) * 64;
            else if (slot < 10) { col = 896 + (slot - 6) * 64; g = gq; } else { col = 1152 + (slot - 10) * 64; g = gk; }
            bf16_t* q = P1 + (size_t)row * P1W + col;
            float d[64];
#pragma unroll
            for (int c8 = 0; c8 < 8; ++c8) {
                const uint4 u = *(const uint4*)(q + c8 * 8);
                d[c8 * 8 + 0] = __uint_as_float(u.x << 16); d[c8 * 8 + 1] = __uint_as_float(u.x & 0xffff0000u); d[c8 * 8 + 2] = __uint_as_float(u.y << 16); d[c8 * 8 + 3] = __uint_as_float(u.y & 0xffff0000u);
                d[c8 * 8 + 4] = __uint_as_float(u.z << 16); d[c8 * 8 + 5] = __uint_as_float(u.z & 0xffff0000u); d[c8 * 8 + 6] = __uint_as_float(u.w << 16); d[c8 * 8 + 7] = __uint_as_float(u.w & 0xffff0000u);
            }
            if (g) {
                float ss = 0.f;
#pragma unroll
                for (int i = 0; i < 64; ++i) ss += d[i] * d[i];
                const float r = rsqrtf(ss * (1.f / 64.f) + EPS);
#pragma unroll
                for (int i = 0; i < 64; ++i) d[i] = d[i] * r * g[i];
            }
            if (lat) {
                const float* tr = ROPE + (size_t)(row & 2047) * 64;
#pragma unroll
                for (int ax = 0; ax < 2; ++ax)
#pragma unroll
                    for (int i4 = 0; i4 < 4; ++i4) {
                        const float4 c4 = *(const float4*)(tr + ax * 16 + i4 * 4), s4 = *(const float4*)(tr + 32 + ax * 16 + i4 * 4);
                        const float cc[4] = {c4.x, c4.y, c4.z, c4.w}, sn[4] = {s4.x, s4.y, s4.z, s4.w};
#pragma unroll
                        for (int j = 0; j < 4; ++j) {
                            const int i1 = ax * 32 + i4 * 4 + j, i2 = i1 + 16;
                            const float x1 = d[i1], x2 = d[i2];
                            d[i1] = x1 * cc[j] - x2 * sn[j]; d[i2] = x2 * cc[j] + x1 * sn[j];
                        }
                    }
            }
#pragma unroll
            for (int c8 = 0; c8 < 8; ++c8) {
                uint4 o; o.x = pk2(d[c8 * 8 + 0], d[c8 * 8 + 1]); o.y = pk2(d[c8 * 8 + 2], d[c8 * 8 + 3]); o.z = pk2(d[c8 * 8 + 4], d[c8 * 8 + 5]); o.w = pk2(d[c8 * 8 + 6], d[c8 * 8 + 7]);
                *(uint4*)(q + c8 * 8) = o;
            }
        }
    }
    const float* __restrict__ cw = PIN(p, I_CONVW) + (size_t)l * 5 * 768; const float* __restrict__ cb = PIN(p, I_CONVB) + (size_t)l * 768;
    for (size_t idx = gtid; idx < (size_t)MT * 64; idx += nthr) {
        const int row = (int)(idx >> 6), ch0 = (int)(idx & 63) * 8;
        int t, len; if (row < ML) { t = row & 2047; len = 2048; } else { t = (row - ML) & 255; len = 256; }
        uint4 u[5];
#pragma unroll
        for (int k = 0; k < 5; ++k) { const int tt = t + k - 2; u[k] = (tt >= 0 && tt < len) ? *(const uint4*)(P1 + (size_t)(row + k - 2) * P1W + 1536 + ch0) : make_uint4(0u, 0u, 0u, 0u); }
        float acc[8];
        { const float4 b0 = *(const float4*)(cb + 256 + ch0), b1 = *(const float4*)(cb + 256 + ch0 + 4); acc[0] = b0.x; acc[1] = b0.y; acc[2] = b0.z; acc[3] = b0.w; acc[4] = b1.x; acc[5] = b1.y; acc[6] = b1.z; acc[7] = b1.w; }
#pragma unroll
        for (int k = 0; k < 5; ++k) {
            const float4 w0 = *(const float4*)(cw + k * 768 + 256 + ch0), w1 = *(const float4*)(cw + k * 768 + 256 + ch0 + 4);
            acc[0] += __uint_as_float(u[k].x << 16) * w0.x; acc[1] += __uint_as_float(u[k].x & 0xffff0000u) * w0.y;
            acc[2] += __uint_as_float(u[k].y << 16) * w0.z; acc[3] += __uint_as_float(u[k].y & 0xffff0000u) * w0.w;
            acc[4] += __uint_as_float(u[k].z << 16) * w1.x; acc[5] += __uint_as_float(u[k].z & 0xffff0000u) * w1.y;
            acc[6] += __uint_as_float(u[k].w << 16) * w1.z; acc[7] += __uint_as_float(u[k].w & 0xffff0000u) * w1.w;
        }
        uint4 o; o.x = pk2(siluf(acc[0]), siluf(acc[1])); o.y = pk2(siluf(acc[2]), siluf(acc[3])); o.z = pk2(siluf(acc[4]), siluf(acc[5])); o.w = pk2(siluf(acc[6]), siluf(acc[7]));
        *(uint4*)(BC + (size_t)row * 512 + ch0) = o;
    }
    for (size_t idx = gtid; idx < (size_t)512 * (MT / 16); idx += nthr) {
        const int ch = (int)(idx / (MT / 16)), m0 = (int)(idx % (MT / 16)) * 16;
        int t0, len; if (m0 < ML) { t0 = m0 & 2047; len = 2048; } else { t0 = (m0 - ML) & 255; len = 256; }
        const bf16_t* src = PT + (size_t)(512 + ch) * MT + m0;
        float in[20];
        const uint4 ua = *(const uint4*)src, ub = *(const uint4*)(src + 8);
        in[2] = __uint_as_float(ua.x << 16); in[3] = __uint_as_float(ua.x & 0xffff0000u); in[4] = __uint_as_float(ua.y << 16); in[5] = __uint_as_float(ua.y & 0xffff0000u);
        in[6] = __uint_as_float(ua.z << 16); in[7] = __uint_as_float(ua.z & 0xffff0000u); in[8] = __uint_as_float(ua.w << 16); in[9] = __uint_as_float(ua.w & 0xffff0000u);
        in[10] = __uint_as_float(ub.x << 16); in[11] = __uint_as_float(ub.x & 0xffff0000u); in[12] = __uint_as_float(ub.y << 16); in[13] = __uint_as_float(ub.y & 0xffff0000u);
        in[14] = __uint_as_float(ub.z << 16); in[15] = __uint_as_float(ub.z & 0xffff0000u); in[16] = __uint_as_float(ub.w << 16); in[17] = __uint_as_float(ub.w & 0xffff0000u);
        in[0] = t0 >= 2 ? bf2f(src[-2]) : 0.f; in[1] = t0 >= 1 ? bf2f(src[-1]) : 0.f;
        in[18] = t0 + 16 < len ? bf2f(src[16]) : 0.f; in[19] = t0 + 17 < len ? bf2f(src[17]) : 0.f;
        const float w0 = cw[ch], w1 = cw[768 + ch], w2 = cw[2 * 768 + ch], w3 = cw[3 * 768 + ch], w4 = cw[4 * 768 + ch], bb = cb[ch];
        float o[16];
#pragma unroll
        for (int i = 0; i < 16; ++i) o[i] = siluf(bb + in[i] * w0 + in[i + 1] * w1 + in[i + 2] * w2 + in[i + 3] * w3 + in[i + 4] * w4);
        uint4 oa, ob; oa.x = pk2(o[0], o[1]); oa.y = pk2(o[2], o[3]); oa.z = pk2(o[4], o[5]); oa.w = pk2(o[6], o[7]);
        ob.x = pk2(o[8], o[9]); ob.y = pk2(o[10], o[11]); ob.z = pk2(o[12], o[13]); ob.w = pk2(o[14], o[15]);
        *(uint4*)(XBT + (size_t)ch * MT + m0) = oa; *(uint4*)(XBT + (size_t)ch * MT + m0 + 8) = ob;
    }
}
struct AttnAcc { f32x4 o[4]; float m, l; };
__device__ __forceinline__ void attn_init(AttnAcc& a) {
#pragma unroll
    for (int i = 0; i < 4; ++i) a.o[i] = (f32x4){0.f, 0.f, 0.f, 0.f};
    a.m = -1e30f; a.l = 0.f;
}
__device__ __forceinline__ void attn_finish(AttnAcc& a, float sink_l2, bool has_sink, bf16_t* yrow, int lane) {
    float l = a.l; l += __shfl_xor(l, 16); l += __shfl_xor(l, 32);
    if (has_sink) l += ex2(sink_l2 - a.m);
    const float inv = 1.f / l; const int quad = lane >> 4;
#pragma unroll
    for (int dt = 0; dt < 4; ++dt) { uint2 o; o.x = pk2(a.o[dt][0] * inv, a.o[dt][1] * inv); o.y = pk2(a.o[dt][2] * inv, a.o[dt][3] * inv); *(uint2*)(yrow + dt * 16 + quad * 4) = o; }
}
__device__ __forceinline__ void load_q(bf16x8 (&qf)[2], const bf16_t* qrow, int lane) { const int quad = lane >> 4; qf[0] = *(const bf16x8*)(qrow + quad * 8); qf[1] = *(const bf16x8*)(qrow + 32 + quad * 8); }

constexpr float SC_ATT = 0.125f * LOG2E;
#define NEG_INF_F (-__builtin_inff())
constexpr int AT_LD = 72;
constexpr int AT_STAGE = 2 * 64 * AT_LD;

__device__ __forceinline__ void attn_step2_lds(AttnAcc& a, const bf16x8 (&qf)[2], const PG8_LAS bf16_t* Kl, const PG8_LAS bf16_t* Vl, int c0, f32x4 add0, f32x4 add1, int lane) {
    const int kr = lane & 15, quad = lane >> 4;
    const PG8_LAS bf16_t* kp = Kl + (c0 + kr) * AT_LD + quad * 8;
    const bf16x8 k00 = *(const PG8_LAS bf16x8*)kp, k01 = *(const PG8_LAS bf16x8*)(kp + 32);
    const bf16x8 k10 = *(const PG8_LAS bf16x8*)(kp + 16 * AT_LD), k11 = *(const PG8_LAS bf16x8*)(kp + 16 * AT_LD + 32);
    bf16x8 va[4];
#pragma unroll
    for (int dt = 0; dt < 4; ++dt) {
        const PG8_LAS bf16_t* vp = Vl + (dt * 16 + kr) * AT_LD + c0 + quad * 4;
        const bf16x4 lo = *(const PG8_LAS bf16x4*)vp, hi = *(const PG8_LAS bf16x4*)(vp + 16);
        va[dt] = __builtin_shufflevector(lo, hi, 0, 1, 2, 3, 4, 5, 6, 7);
    }
    f32x4 s0 = (f32x4){0.f, 0.f, 0.f, 0.f}, s1 = (f32x4){0.f, 0.f, 0.f, 0.f};
    s0 = MFMA32(k00, qf[0], s0); s1 = MFMA32(k10, qf[0], s1); s0 = MFMA32(k01, qf[1], s0); s1 = MFMA32(k11, qf[1], s1);
    float v[8];
#pragma unroll
    for (int j = 0; j < 4; ++j) { v[j] = s0[j] * SC_ATT + add0[j]; v[4 + j] = s1[j] * SC_ATT + add1[j]; }
    float tm = fmaxf(fmaxf(fmaxf(v[0], v[1]), fmaxf(v[2], v[3])), fmaxf(fmaxf(v[4], v[5]), fmaxf(v[6], v[7])));
    tm = fmaxf(tm, __shfl_xor(tm, 16)); tm = fmaxf(tm, __shfl_xor(tm, 32));
    const float mn = fmaxf(a.m, tm);
    if (__any(mn > a.m)) {
        const float alpha = ex2(a.m - mn);
        a.l *= alpha;
#pragma unroll
        for (int dt = 0; dt < 4; ++dt) a.o[dt] *= alpha;
        a.m = mn;
    }
    float ps = 0.f; u32x4 pw;
#pragma unroll
    for (int j = 0; j < 4; ++j) { const float pa = ex2(v[2 * j] - mn), pc = ex2(v[2 * j + 1] - mn); ps += pa + pc; pw[j] = pk2(pa, pc); }
    a.l += ps;
    const bf16x8 pb = __builtin_bit_cast(bf16x8, pw);
#pragma unroll
    for (int dt = 0; dt < 4; ++dt) a.o[dt] = MFMA32(va[dt], pb, a.o[dt]);
}
__device__ __forceinline__ void attn_step4_lds(AttnAcc& a, const bf16x8 (&qf)[2], const PG8_LAS bf16_t* Kl, const PG8_LAS bf16_t* Vl, int lane) {
    const int kr = lane & 15, quad = lane >> 4;
    const PG8_LAS bf16_t* kp = Kl + kr * AT_LD + quad * 8;
    f32x4 sv[4];
#pragma unroll
    for (int t = 0; t < 4; ++t) {
        const bf16x8 k0 = *(const PG8_LAS bf16x8*)(kp + t * 16 * AT_LD), k1 = *(const PG8_LAS bf16x8*)(kp + t * 16 * AT_LD + 32);
        f32x4 z = (f32x4){0.f, 0.f, 0.f, 0.f};
        z = MFMA32(k0, qf[0], z); sv[t] = MFMA32(k1, qf[1], z);
    }
    float tm = sv[0][0];
#pragma unroll
    for (int t = 0; t < 4; ++t)
#pragma unroll
        for (int j = 0; j < 4; ++j) tm = fmaxf(tm, sv[t][j]);
    tm *= SC_ATT;
    tm = fmaxf(tm, __shfl_xor(tm, 16)); tm = fmaxf(tm, __shfl_xor(tm, 32));
    const float mn = fmaxf(a.m, tm);
    if (__any(mn > a.m)) {
        const float alpha = ex2(a.m - mn);
        a.l *= alpha;
#pragma unroll
        for (int dt = 0; dt < 4; ++dt) a.o[dt] *= alpha;
        a.m = mn;
    }
    float ps = 0.f; u32x4 pw[2];
#pragma unroll
    for (int h2 = 0; h2 < 2; ++h2)
#pragma unroll
        for (int j = 0; j < 4; ++j) {
            const int t = h2 * 2 + (j >> 1), e = (j & 1) * 2;
            const float pa = ex2(__builtin_fmaf(sv[t][e], SC_ATT, -mn)), pc = ex2(__builtin_fmaf(sv[t][e + 1], SC_ATT, -mn));
            ps += pa + pc; pw[h2][j] = pk2(pa, pc);
        }
    a.l += ps;
#pragma unroll
    for (int h2 = 0; h2 < 2; ++h2) {
        const bf16x8 pb = __builtin_bit_cast(bf16x8, pw[h2]);
#pragma unroll
        for (int dt = 0; dt < 4; ++dt) {
            const PG8_LAS bf16_t* vp = Vl + (dt * 16 + kr) * AT_LD + h2 * 32 + quad * 4;
            const bf16x4 lo = *(const PG8_LAS bf16x4*)vp, hi = *(const PG8_LAS bf16x4*)(vp + 16);
            a.o[dt] = MFMA32(__builtin_shufflevector(lo, hi, 0, 1, 2, 3, 4, 5, 6, 7), pb, a.o[dt]);
        }
    }
}
template <class TileFn, class WaveFn>
__device__ __forceinline__ void attn_block_loop(int ntiles, int kcol, int vrow, const bf16_t* __restrict__ P1, const bf16_t* __restrict__ PT, PG8_LAS bf16_t* lds, int tid, TileFn tile_row, WaveFn wf) {
    const int r = tid >> 3, c = tid & 7;
    u32x4 kreg, vreg;
    { const size_t row0 = tile_row(0); kreg = *(const u32x4*)(P1 + (row0 + r) * P1W + kcol + c * 8); vreg = *(const u32x4*)(PT + (size_t)(vrow + r) * MT + row0 + c * 8); }
    *(PG8_LAS u32x4*)(lds + r * AT_LD + c * 8) = kreg; *(PG8_LAS u32x4*)(lds + 64 * AT_LD + r * AT_LD + c * 8) = vreg;
    __syncthreads();
#pragma unroll 1
    for (int ti = 0; ti < ntiles; ++ti) {
        PG8_LAS bf16_t* cur = lds + (ti & 1) * AT_STAGE; PG8_LAS bf16_t* nxt = lds + ((ti + 1) & 1) * AT_STAGE;
        const bool more = ti + 1 < ntiles;
        if (more) { const size_t row0 = tile_row(ti + 1); kreg = *(const u32x4*)(P1 + (row0 + r) * P1W + kcol + c * 8); vreg = *(const u32x4*)(PT + (size_t)(vrow + r) * MT + row0 + c * 8); }
        wf(ti, cur, cur + 64 * AT_LD);
        if (more) { *(PG8_LAS u32x4*)(nxt + r * AT_LD + c * 8) = kreg; *(PG8_LAS u32x4*)(nxt + 64 * AT_LD + r * AT_LD + c * 8) = vreg; }
        __syncthreads();
    }
}
__device__ __forceinline__ void ga_block(const Params& p, int u, PG8_LAS bf16_t* lds) {
    const bf16_t* P1 = (const bf16_t*)(WSP(p) + OFF_BIG); const bf16_t* PT = (const bf16_t*)(WSP(p) + OFF_PT); bf16_t* Y = (bf16_t*)(WSP(p) + OFF_Y);
    const int tid = TIDX, lane = tid & 63, wave = tid >> 6;
    const int qb = u & 15, qh = (u >> 4) & 3, b = u >> 6, kvh = qh >> 1;
    const size_t qrow = (size_t)b * 2048 + qb * 128 + wave * 16 + (lane & 15);
    bf16x8 qf[2]; load_q(qf, P1 + qrow * P1W + 896 + qh * 64, lane);
    AttnAcc a; attn_init(a);
    const f32x4 z = (f32x4){0.f, 0.f, 0.f, 0.f};
    attn_block_loop(36, 1152 + kvh * 64, 384 + kvh * 64, P1, PT, lds, tid,
        [&](int ti) -> size_t { return ti < 4 ? (size_t)ML + b * 256 + ti * 64 : (size_t)b * 2048 + (ti - 4) * 64; },
        [&](int ti, const PG8_LAS bf16_t* Kl, const PG8_LAS bf16_t* Vl) {
            attn_step4_lds(a, qf, Kl, Vl, lane);
        });
    attn_finish(a, 0.f, false, Y + qrow * 1024 + 512 + qh * 64, lane);
}
__device__ __forceinline__ void wa_block(const Params& p, int l, int u, PG8_LAS bf16_t* lds) {
    const bf16_t* P1 = (const bf16_t*)(WSP(p) + OFF_BIG); const bf16_t* PT = (const bf16_t*)(WSP(p) + OFF_PT); bf16_t* Y = (bf16_t*)(WSP(p) + OFF_Y);
    const int tid = TIDX, lane = tid & 63, wave = tid >> 6, quad = lane >> 4;
    const int qb = u & 15, qh = (u >> 4) & 3, b = u >> 6, kvh = qh >> 1;
    const int i0 = qb * 128 + wave * 16, i = i0 + (lane & 15);
    const size_t qrow = (size_t)b * 2048 + i;
    bf16x8 qf[2]; load_q(qf, P1 + qrow * P1W + qh * 64, lane);
    AttnAcc a; attn_init(a);
    const int jlo = max(qb * 128 - 128, 0), jhi = min(qb * 128 + 256, 2048);
    const f32x4 z = (f32x4){0.f, 0.f, 0.f, 0.f};
    attn_block_loop(4 + (jhi - jlo) / 64, 256 + kvh * 64, kvh * 64, P1, PT, lds, tid,
        [&](int ti) -> size_t { return ti < 4 ? (size_t)ML + b * 256 + ti * 64 : (size_t)b * 2048 + jlo + (ti - 4) * 64; },
        [&](int ti, const PG8_LAS bf16_t* Kl, const PG8_LAS bf16_t* Vl) {
            if (ti < 4) {
                attn_step4_lds(a, qf, Kl, Vl, lane);
            } else {
                const int j0t = jlo + (ti - 4) * 64;
#pragma unroll
                for (int pr = 0; pr < 2; ++pr) {
                    const int j0 = j0t + pr * 32;
                    if (j0 + 16 >= i0 - 128 && j0 <= i0 + 128) {
                        f32x4 add0, add1;
#pragma unroll
                        for (int jj = 0; jj < 4; ++jj) {
                            const int d0 = i - (j0 + quad * 4 + jj), d1 = d0 - 16;
                            add0[jj] = (d0 <= 128 && d0 >= -128) ? 0.f : NEG_INF_F; add1[jj] = (d1 <= 128 && d1 >= -128) ? 0.f : NEG_INF_F;
                        }
                        attn_step2_lds(a, qf, Kl, Vl, pr * 32, add0, add1, lane);
                    }
                }
            }
        });
    attn_finish(a, PIN(p, I_SINK)[l * 4 + qh] * LOG2E, true, Y + qrow * 1024 + qh * 64, lane);
}
__device__ __forceinline__ void na_block(const Params& p, int l, int u, PG8_LAS bf16_t* lds) {
    const bf16_t* P1 = (const bf16_t*)(WSP(p) + OFF_BIG); const bf16_t* PT = (const bf16_t*)(WSP(p) + OFF_PT); bf16_t* Y = (bf16_t*)(WSP(p) + OFF_Y);
    const int tid = TIDX, lane = tid & 63, wave = tid >> 6, quad = lane >> 4;
    const int rp = u & 15, h = (u >> 4) & 3, b = u >> 6;
    const int r0 = rp * 2, r = r0 + (wave >> 2), jb = wave & 3;
    const size_t qrow = (size_t)b * 2048 + r * 64 + jb * 16 + (lane & 15);
    bf16x8 qf[2]; load_q(qf, P1 + qrow * P1W + 384 + h * 64, lane);
    AttnAcc a; attn_init(a);
    const int rs0 = min(max(r0 - 4, 0), 24), rs1 = min(max(r0 + 1 - 4, 0), 24), nrows = rs1 + 8 - rs0;
    const int rs = min(max(r - 4, 0), 24), kcol_start = min(max(jb * 16 - 8, 0), 32);
    const int qc = jb * 16 + (lane & 15), qcs = min(max(qc - 8, 0), 48);
    const float* rpb = PIN(p, I_RPB) + (size_t)(l * 4 + h) * 15 * 31;
    const f32x4 z = (f32x4){0.f, 0.f, 0.f, 0.f};
    attn_block_loop(4 + nrows, 640 + h * 64, 128 + h * 64, P1, PT, lds, tid,
        [&](int ti) -> size_t { return ti < 4 ? (size_t)ML + b * 256 + ti * 64 : (size_t)b * 2048 + (rs0 + ti - 4) * 64; },
        [&](int ti, const PG8_LAS bf16_t* Kl, const PG8_LAS bf16_t* Vl) {
            if (ti < 4) {
                attn_step4_lds(a, qf, Kl, Vl, lane);
            } else {
                const int keyrow = rs0 + ti - 4;
                if (keyrow >= rs && keyrow < rs + 8) {
                    const int dr = keyrow - r + 7;
                    f32x4 add0, add1;
#pragma unroll
                    for (int jj = 0; jj < 4; ++jj) {
                        const int kc0 = kcol_start + quad * 4 + jj, kc1 = kc0 + 16;
                        const bool ok0 = kc0 >= qcs && kc0 < qcs + 16, ok1 = kc1 >= qcs && kc1 < qcs + 16;
                        const int dc0 = min(max(kc0 - qc + 15, 0), 30), dc1 = min(max(kc1 - qc + 15, 0), 30);
                        add0[jj] = ok0 ? rpb[dr * 31 + dc0] * LOG2E : NEG_INF_F; add1[jj] = ok1 ? rpb[dr * 31 + dc1] * LOG2E : NEG_INF_F;
                    }
                    attn_step2_lds(a, qf, Kl, Vl, kcol_start, add0, add1, lane);
                }
            }
        });
    attn_finish(a, 0.f, false, Y + qrow * 1024 + 256 + h * 64, lane);
}
__device__ __forceinline__ void ctx_block(const Params& p, int l, int u, PG8_LAS bf16_t* lds) {
    const bf16_t* P1 = (const bf16_t*)(WSP(p) + OFF_BIG); const bf16_t* PT = (const bf16_t*)(WSP(p) + OFF_PT); bf16_t* Y = (bf16_t*)(WSP(p) + OFF_Y);
    const int tid = TIDX, lane = tid & 63, wave = tid >> 6;
    const int half = u & 1, h = (u >> 1) & 3, b = (u >> 3) & 7, mx = u >> 6;
    const size_t qrow = (size_t)ML + b * 256 + half * 128 + wave * 16 + (lane & 15);
    int qcol, kcol, vrow;
    if (mx == 0) { qcol = h * 64; kcol = 256 + (h >> 1) * 64; vrow = (h >> 1) * 64; }
    else if (mx == 1) { qcol = 384 + h * 64; kcol = 640 + h * 64; vrow = 128 + h * 64; }
    else { qcol = 896 + h * 64; kcol = 1152 + (h >> 1) * 64; vrow = 384 + (h >> 1) * 64; }
    bf16x8 qf[2]; load_q(qf, P1 + qrow * P1W + qcol, lane);
    AttnAcc a; attn_init(a);
    const f32x4 z = (f32x4){0.f, 0.f, 0.f, 0.f};
    attn_block_loop(4, kcol, vrow, P1, PT, lds, tid,
        [&](int ti) -> size_t { return (size_t)ML + b * 256 + ti * 64; },
        [&](int ti, const PG8_LAS bf16_t* Kl, const PG8_LAS bf16_t* Vl) {
            attn_step4_lds(a, qf, Kl, Vl, lane);
        });
    attn_finish(a, PIN(p, I_SINK)[l * 4 + h] * LOG2E, mx == 0, Y + qrow * 1024 + mx * 256 + h * 64, lane);
}

__device__ __forceinline__ size_t chunk_row0(int b, int k) { return k < 2 ? (size_t)ML + b * 256 + k * 128 : (size_t)b * 2048 + (k - 2) * 128; }
__device__ __forceinline__ void ssm_a_item(const Params& p, int l, int item, PG8_LAS float* lf) {
    unsigned char* ws = WSP(p);
    const bf16_t* XBT = (const bf16_t*)(ws + OFF_XBT); const float* DT = (const float*)(ws + OFF_DT);
    float* CUM = (float*)(ws + OFF_CUM); float* TOT = (float*)(ws + OFF_TOT); float* ST = (float*)(ws + OFF_ST);
    const int b = item / 18, k = item % 18, tid = TIDX, lane = tid & 63, wave = tid >> 6, h = wave & 3, dir = wave >> 2, j8 = dir * 4 + h, quad = lane >> 4, fr = lane & 15;
    const size_t m0 = chunk_row0(b, k);
    const float av = -__expf(PIN(p, I_ALOG)[l * 8 + j8]);
    const float d0 = DT[(m0 + lane) * 8 + j8], d1 = DT[(m0 + 64 + lane) * 8 + j8];
    const float v0 = d0 * av, v1 = d1 * av;
    float p0 = v0, p1 = v1;
#pragma unroll
    for (int o = 1; o < 64; o <<= 1) { const float t0 = __shfl_up(p0, o), t1 = __shfl_up(p1, o); if (lane >= o) { p0 += t0; p1 += t1; } }
    const float tot0 = __shfl(p0, 63), tot1 = __shfl(p1, 63), tot = tot0 + tot1;
    float c0, c1;
    if (dir == 0) { c0 = p0; c1 = tot0 + p1; } else { c0 = tot - (p0 - v0); c1 = tot - (tot0 + p1 - v1); }
    CUM[(m0 + lane) * 8 + j8] = c0; CUM[(m0 + 64 + lane) * 8 + j8] = c1;
    if (lane == 0) TOT[(size_t)(b * 18 + k) * 8 + j8] = tot;
    PG8_LAS float* sw = lf + wave * 128;
    sw[lane] = d0 * __expf(tot - c0); sw[lane + 64] = d1 * __expf(tot - c1);
    __syncthreads();
    const int g = h >> 1;
    const bf16_t* xT = XBT + (size_t)(h * 64) * MT + m0; const bf16_t* bT = XBT + (size_t)(256 + g * 128) * MT + m0;
    float* dst = ST + ((size_t)(b * 18 + k) * 8 + j8) * 8192;
#pragma unroll 1
    for (int nh = 0; nh < 2; ++nh) {
        f32x4 acc[4][4];
#pragma unroll
        for (int i = 0; i < 4; ++i)
#pragma unroll
            for (int j = 0; j < 4; ++j) acc[i][j] = (f32x4){0.f, 0.f, 0.f, 0.f};
#pragma unroll 1
        for (int ks = 0; ks < 4; ++ks) {
            const int l0 = ks * 32 + quad * 8;
            bf16x8 af[4];
#pragma unroll
            for (int pt = 0; pt < 4; ++pt) {
                const bf16x8 xv = *(const bf16x8*)(xT + (size_t)(pt * 16 + fr) * MT + l0);
#pragma unroll
                for (int j = 0; j < 8; ++j) af[pt][j] = (short)f2bf(bf2f((bf16_t)xv[j]) * sw[l0 + j]);
            }
#pragma unroll
            for (int nt = 0; nt < 4; ++nt) {
                const bf16x8 bv = *(const bf16x8*)(bT + (size_t)((nh * 4 + nt) * 16 + fr) * MT + l0);
#pragma unroll
                for (int pt = 0; pt < 4; ++pt) acc[pt][nt] = MFMA32(af[pt], bv, acc[pt][nt]);
            }
        }
#pragma unroll
        for (int pt = 0; pt < 4; ++pt)
#pragma unroll
            for (int nt = 0; nt < 4; ++nt)
#pragma unroll
                for (int j = 0; j < 4; ++j) dst[(pt * 16 + quad * 4 + j) * 128 + (nh * 4 + nt) * 16 + fr] = acc[pt][nt][j];
    }
    __syncthreads();
}
__device__ __forceinline__ void phase_ssm_scan(const Params& p) {
    unsigned char* ws = WSP(p);
    const float* ST = (const float*)(ws + OFF_ST); const float* TOT = (const float*)(ws + OFF_TOT); bf16_t* SIN = (bf16_t*)(ws + OFF_SIN);
    const size_t nthr = (size_t)gridDim.x * 512;
    for (size_t idx = (size_t)BIDX * 512 + TIDX; idx < (size_t)NBATCH * 8 * 2048; idx += nthr) {
        const int e4 = (int)(idx & 2047), j8 = (int)(idx >> 11) & 7, b = (int)(idx >> 14), dir = j8 >> 2;
        float4 sv = make_float4(0.f, 0.f, 0.f, 0.f);
#pragma unroll 1
        for (int s0 = 0; s0 < 18; s0 += 6) {
            float4 tv[6]; float dec[6];
#pragma unroll
            for (int q = 0; q < 6; ++q) {
                const int st = s0 + q, kk = dir == 0 ? st : (st < 2 ? 1 - st : 19 - st);
                tv[q] = *(const float4*)(ST + ((size_t)(b * 18 + kk) * 8 + j8) * 8192 + e4 * 4);
                dec[q] = TOT[(size_t)(b * 18 + kk) * 8 + j8];
            }
#pragma unroll
            for (int q = 0; q < 6; ++q) {
                const int st = s0 + q, kk = dir == 0 ? st : (st < 2 ? 1 - st : 19 - st);
                const size_t base = ((size_t)(b * 18 + kk) * 8 + j8) * 8192 + e4 * 4;
                uint2 o; o.x = pk2(sv.x, sv.y); o.y = pk2(sv.z, sv.w);
                *(uint2*)(SIN + base) = o;
                const float d = __expf(dec[q]); const float4 t = tv[q];
                sv.x = sv.x * d + t.x; sv.y = sv.y * d + t.y; sv.z = sv.z * d + t.z; sv.w = sv.w * d + t.w;
            }
        }
    }
}
#ifndef SSMB_UNROLL_H
#define SSMB_UNROLL_H 4
#endif
constexpr int SS_LD = 136;
__device__ __forceinline__ void ssm_b_item(const Params& p, int l, int item, PG8_LAS unsigned char* lds) {
    unsigned char* ws = WSP(p);
    const bf16_t* XBT = (const bf16_t*)(ws + OFF_XBT); const bf16_t* BC = (const bf16_t*)(ws + OFF_BC); const bf16_t* P1 = (const bf16_t*)(ws + OFF_BIG);
    const float* DT = (const float*)(ws + OFF_DT); const float* CUM = (const float*)(ws + OFF_CUM); const float* TOT = (const float*)(ws + OFF_TOT); const float* ST = (const float*)(ws + OFF_ST);
    bf16_t* Y = (bf16_t*)(ws + OFF_Y);
    const int b = item / 18, k = item % 18, tid = TIDX, lane = tid & 63, wave = tid >> 6, quad = lane >> 4, fr = lane & 15;
    const size_t m0 = chunk_row0(b, k);
    const bf16_t* SIN = (const bf16_t*)(ws + OFF_SIN) + (size_t)(b * 18 + k) * 8 * 8192;
    PG8_LAS float* ysb = (PG8_LAS float*)lds;
    PG8_LAS float* scum = (PG8_LAS float*)(lds + 131072);
    PG8_LAS float* sdt = scum + 1024;
    for (int i = tid; i < 1024; i += 512) { scum[i] = CUM[m0 * 8 + i]; sdt[i] = DT[m0 * 8 + i]; }
    __syncthreads();
    const int t = wave * 16 + fr; const size_t mt = m0 + t;
    float ss = 0.f;
#pragma unroll 1
    for (int h = 0; h < 4; ++h) {
        const int g = h >> 1;
        bf16x8 cf[4];
#pragma unroll
        for (int ks = 0; ks < 4; ++ks) cf[ks] = *(const bf16x8*)(BC + mt * 512 + 256 + g * 128 + ks * 32 + quad * 8);
        const float cumF_t = scum[t * 8 + h], revB_t = scum[t * 8 + 4 + h];
        f32x4 yacc[4];
#pragma unroll
        for (int pt = 0; pt < 4; ++pt) yacc[pt] = (f32x4){0.f, 0.f, 0.f, 0.f};
#pragma unroll 1
        for (int sp = 0; sp < 4; ++sp) {
            bf16x8 bfr[2][4]; bf16x4 xa[2][4];
#pragma unroll
            for (int q = 0; q < 2; ++q) {
                const int st = sp * 2 + q;
                const bf16_t* brow = BC + (m0 + st * 16 + fr) * 512 + g * 128 + quad * 8;
#pragma unroll
                for (int ks = 0; ks < 4; ++ks) bfr[q][ks] = *(const bf16x8*)(brow + ks * 32);
#pragma unroll
                for (int pt = 0; pt < 4; ++pt) xa[q][pt] = *(const bf16x4*)(XBT + (size_t)(h * 64 + pt * 16 + fr) * MT + m0 + st * 16 + quad * 4);
            }
#pragma unroll
            for (int q = 0; q < 2; ++q) {
                const int st = sp * 2 + q;
                f32x4 G = (f32x4){0.f, 0.f, 0.f, 0.f};
#pragma unroll
                for (int ks = 0; ks < 4; ++ks) G = MFMA32(bfr[q][ks], cf[ks], G);
                bf16x4 pb;
#pragma unroll
                for (int j = 0; j < 4; ++j) {
                    const int s_ = st * 16 + quad * 4 + j;
                    const float eF = s_ <= t ? cumF_t - scum[s_ * 8 + h] : NEG_INF_F, eB = s_ >= t ? revB_t - scum[s_ * 8 + 4 + h] : NEG_INF_F;
                    const float w = __expf(eF) * sdt[s_ * 8 + h] + __expf(eB) * sdt[s_ * 8 + 4 + h];
                    pb[j] = (short)f2bf(G[j] * w);
                }
#pragma unroll
                for (int pt = 0; pt < 4; ++pt) yacc[pt] = MFMA16(xa[q][pt], pb, yacc[pt]);
            }
        }
#pragma unroll
        for (int dir = 0; dir < 2; ++dir) {
            bf16x8 sf[16];
#pragma unroll
            for (int ks = 0; ks < 4; ++ks)
#pragma unroll
                for (int pt = 0; pt < 4; ++pt) sf[ks * 4 + pt] = *(const bf16x8*)(SIN + (size_t)((dir * 4 + h) * 64 + pt * 16 + fr) * 128 + ks * 32 + quad * 8);
            f32x4 a2[4];
#pragma unroll
            for (int pt = 0; pt < 4; ++pt) a2[pt] = (f32x4){0.f, 0.f, 0.f, 0.f};
#pragma unroll
            for (int ks = 0; ks < 4; ++ks)
#pragma unroll
                for (int pt = 0; pt < 4; ++pt) a2[pt] = MFMA32(sf[ks * 4 + pt], cf[ks], a2[pt]);
            const float e = __expf(dir == 0 ? cumF_t : revB_t);
#pragma unroll
            for (int pt = 0; pt < 4; ++pt) yacc[pt] += e * a2[pt];
        }
        const float Dh = PIN(p, I_SSMD)[l * 4 + h];
        PG8_LAS float* ys = ysb + (h * 8 + wave) * 1024;
#pragma unroll
        for (int pt = 0; pt < 4; ++pt) {
            const uint2 zz = *(const uint2*)(P1 + mt * P1W + 1280 + h * 64 + pt * 16 + quad * 4);
            const float z0 = __uint_as_float(zz.x << 16), z1 = __uint_as_float(zz.x & 0xffff0000u), z2 = __uint_as_float(zz.y << 16), z3 = __uint_as_float(zz.y & 0xffff0000u);
            const bf16_t* xp = XBT + (size_t)(h * 64 + pt * 16 + quad * 4) * MT + mt;
            f32x4 y;
            y[0] = (yacc[pt][0] + Dh * bf2f(xp[0])) * siluf(z0); y[1] = (yacc[pt][1] + Dh * bf2f(xp[MT])) * siluf(z1);
            y[2] = (yacc[pt][2] + Dh * bf2f(xp[2 * (size_t)MT])) * siluf(z2); y[3] = (yacc[pt][3] + Dh * bf2f(xp[3 * (size_t)MT])) * siluf(z3);
            ss += y[0] * y[0] + y[1] * y[1] + y[2] * y[2] + y[3] * y[3];
            *(PG8_LAS f32x4*)(ys + (pt * 64 + lane) * 4) = y;
        }
    }
    ss += __shfl_xor(ss, 16); ss += __shfl_xor(ss, 32);
    const float rstd = rsqrtf(ss * (1.f / 256.f) + EPS);
    const float* gn = PIN(p, I_SSMN) + l * 256;
#pragma unroll 1
    for (int h = 0; h < 4; ++h) {
        PG8_LAS float* ys = ysb + (h * 8 + wave) * 1024;
#pragma unroll
        for (int pt = 0; pt < 4; ++pt) {
            const f32x4 y = *(PG8_LAS f32x4*)(ys + (pt * 64 + lane) * 4);
            const int c = h * 64 + pt * 16 + quad * 4; const float4 g4 = *(const float4*)(gn + c);
            uint2 o; o.x = pk2(y[0] * rstd * g4.x, y[1] * rstd * g4.y); o.y = pk2(y[2] * rstd * g4.z, y[3] * rstd * g4.w);
            *(uint2*)(Y + mt * 1024 + 768 + c) = o;
        }
    }
    __syncthreads();
}

#define XB_TID ((int)threadIdx.x)
#define XB_TMO      128
#define XB_XCNT(j)  (256  + 64 * (j))
#define XB_XSUB(j)  (1280 + 64 * (j))
#define XB_XGEN(j)  (2304 + 64 * (j))
#define XB_TOP      3328
#define XB_TOPGEN   3392
#define XCD_BAR_WORDS 3456
#define XB_SPIN_CAP (1u << 18)
#define LAS PG8_LAS

__device__ __forceinline__ unsigned xb_ld(unsigned* p)              { return __hip_atomic_load(p, __ATOMIC_RELAXED, __HIP_MEMORY_SCOPE_AGENT); }
__device__ __forceinline__ unsigned xb_add(unsigned* p, unsigned v) { return __hip_atomic_fetch_add(p, v, __ATOMIC_RELAXED, __HIP_MEMORY_SCOPE_AGENT); }
__device__ __forceinline__ unsigned xb_xcc_id() { return (unsigned)__builtin_amdgcn_s_getreg((3 << 11) | 20) & 0xFu; }
#define XB_SPIN(cond, bar) do { unsigned _sp = 0; while (cond) { __builtin_amdgcn_s_sleep(1); \
    if ((++_sp & 255u) == 0u) { if (xb_ld(&(bar)[XB_TMO])) break; if (_sp > XB_SPIN_CAP) { atomicAdd(&(bar)[XB_TMO], 1u); break; } } } } while (0)

struct XcdBarrier {
    unsigned* bar; unsigned x;
    volatile LAS unsigned* st;
};

__device__ __forceinline__ XcdBarrier xcd_barrier_post(unsigned* bar, volatile LAS unsigned* st) {
    XcdBarrier b; b.bar = bar; b.x = xb_xcc_id(); b.st = st;
    if (XB_TID == 0) (void)xb_add(&bar[XB_XCNT(b.x)], 1u);
    return b;
}
__device__ __forceinline__ void xcd_barrier_complete(unsigned* bar, unsigned x, unsigned& nloc, unsigned& nx) {
    const unsigned G = gridDim.x * gridDim.y * gridDim.z;
    unsigned sum, cnt, mine, sp = 0u;
    for (;;) {
        sum = 0u; cnt = 0u; mine = 0u;
#pragma unroll
        for (unsigned j = 0; j < 16; ++j) { const unsigned c = xb_ld(&bar[XB_XCNT(j)]); sum += c; cnt += (c > 0u) ? 1u : 0u; mine = (j == x) ? c : mine; }
        if (sum == G) break;
        __builtin_amdgcn_s_sleep(1);
        if ((++sp & 255u) == 0u) { if (xb_ld(&bar[XB_TMO])) break; if (sp > XB_SPIN_CAP) { atomicAdd(&bar[XB_TMO], 1u); break; } }
    }
    nloc = mine > 0u ? mine : 1u; nx = cnt > 0u ? cnt : 1u;
}

__device__ __forceinline__ void xcd_barrier(const XcdBarrier& b) {
    asm volatile("s_waitcnt vmcnt(0)" ::: "memory");
    __syncthreads();
    if (XB_TID == 0) {
        unsigned* bar = b.bar;
        __builtin_amdgcn_s_waitcnt(0);
        unsigned nloc = b.st[0], nx = b.st[1];
        if (nloc == 0u) { xcd_barrier_complete(bar, b.x, nloc, nx); b.st[0] = nloc; b.st[1] = nx; }
        const unsigned old = xb_add(&bar[XB_XSUB(b.x)], 1u);
        const unsigned gen = old / nloc;
        if (old + 1u == (gen + 1u) * nloc) {
            __builtin_amdgcn_fence(__ATOMIC_RELEASE, "agent");
            asm volatile("s_waitcnt vmcnt(0)" ::: "memory");
            const unsigned og = xb_add(&bar[XB_TOP], 1u);
            const unsigned tg = og / nx;
            if (og + 1u == (tg + 1u) * nx) xb_add(&bar[XB_TOPGEN], 1u);
            else XB_SPIN(xb_ld(&bar[XB_TOPGEN]) == tg, bar);
            __builtin_amdgcn_fence(__ATOMIC_ACQUIRE, "agent");
            xb_add(&bar[XB_XGEN(b.x)], 1u);
            asm volatile("s_waitcnt vmcnt(0)" ::: "memory");
        } else {
            XB_SPIN(xb_ld(&bar[XB_XGEN(b.x)]) == gen, bar);
            __builtin_amdgcn_fence(__ATOMIC_ACQUIRE, "agent");
            asm volatile("s_waitcnt vmcnt(0)" ::: "memory");
        }
    }
    __syncthreads();
}


#ifndef GALIGN
#define GALIGN true
#endif
#ifndef GSP2
#define GSP2 true
#endif
template <class Epi>
__device__ __forceinline__ void run_gemm(PG8_LAS unsigned char* lds, const bf16_t* A, const bf16_t* Bt, int K, int M, int N, const bf16_t* A2, const bf16_t* Bt2, int M2, int N2, const Epi& E) {
    A = opq_p(A); Bt = opq_p(Bt); A2 = opq_p(A2); Bt2 = opq_p(Bt2);
    Gemm g; g.A = A; g.Bt = Bt; g.A2 = A2; g.Bt2 = Bt2; g.M = M; g.N = N; g.K = K;
    StaticOrder S; S.init(M, N, K, (int)gridDim.x, (int)BIDX, M2, N2);
#ifndef NO_GEMM
    gemm_phase<Epi, StaticOrder, GALIGN, GSP2>(lds, g, S, E);
#endif
}

struct EpiAny {
    static constexpr bool PERM = false, AFTER_DRAIN = false;
    int kind; bf16_t* C; long ldc; bf16_t* C2; long ldc2; float* X; const float* modl; int idx; float coef; const bf16_t* P1; const float* bg; bf16_t* Gb;
    __device__ __forceinline__ bool hook_on() const { return kind == 3; }
    __device__ __forceinline__ void hook(f32x4 (&acc)[2][2][4][2], const Unit& u, int wr, int wc, int fr, int fq, int kb) const { EpiBranch E; E.P1 = P1; E.bg = bg; E.Gb = Gb; E.hook(acc, u, wr, wc, fr, fq, kb); }
    __device__ __forceinline__ void operator()(const f32x4 (&acc)[2][2][4][2], const Unit& u, int wr, int wc, int fr, int fq) const {
        if (kind == 0) { EpiStore E; E.C = u.split ? C2 : C; E.ldc = u.split ? ldc2 : ldc; E(acc, u, wr, wc, fr, fq); }
        else if (kind == 1) { EpiGateUp E; E.C = C; E(acc, u, wr, wc, fr, fq); }
        else if (kind == 2) { EpiResid E; E.X = X; E.modl = modl; E.idx = idx; E.coef = coef; E(acc, u, wr, wc, fr, fq); }
        else { EpiBranch E; E.P1 = P1; E.bg = bg; E.Gb = Gb; E(acc, u, wr, wc, fr, fq); }
    }
};

__global__ void __launch_bounds__(512, 2) hybrid_fwd(Params p) {
    extern __shared__ __attribute__((aligned(16))) unsigned char lds_raw[];
    PG8_LAS unsigned char* lds = (PG8_LAS unsigned char*)lds_raw;
    PG8_LAS float* lf = (PG8_LAS float*)lds;
    cg::grid_group grid = cg::this_grid();
    __shared__ uint4 xb_words;
    if (threadIdx.x == 0) xb_words = make_uint4(0u, 0u, 0u, 0u);
    __syncthreads();
    const XcdBarrier xbar = xcd_barrier_post((unsigned*)(ws_load() + OFF_BAR), (volatile PG8_LAS unsigned*)&xb_words);
#ifdef NO_SYNC
#define GSYNC() __syncthreads()
#else
#define GSYNC() xcd_barrier(xbar)
#endif
#ifndef NO_P0
    phase_mod(p, lf);
    phase_copy_x(p);
    phase_rope_table();
    convert_layer(p, 0, lf);
#endif
    grid.sync();
#pragma unroll 1
    for (int l0 = 0; l0 < DEPTH; ++l0) {
        int l = opq_i(l0);
#pragma unroll 1
        for (int gi0 = 0; gi0 < 8; ++gi0) {
            int gi = opq_i(gi0);
            unsigned char* ws = ws_load();
            if (gi == 0) {
                phase_ada<false>(p, PIN(p, I_NFFN1) + l * 1024, l, 0, 1, lf);
                GSYNC();
            } else if (gi == 2) {
                phase_ada<true>(p, PIN(p, I_NMIX) + l * 1024, l, 3, 4, lf);
                GSYNC();
            } else if (gi == 4) {
#ifndef NO_PREP
                phase_prep(p, l);
#endif
                GSYNC();
                {
                    PG8_LAS bf16_t* lb = (PG8_LAS bf16_t*)lds;
                    {
                        const int bid = BIDX, G = (int)gridDim.x;
                        if (G == 256) {
                            int a0, step, lim;
                            if (bid < 144) { ssm_a_item(p, l, bid, lf); a0 = 672 + bid; step = 144; lim = 1216; }
                            else { a0 = bid - 144; step = 112; lim = 672; }
                            for (int a = a0; a < lim; a += step) {
                                if (a < 512) wa_block(p, l, a, lb);
                                else if (a < 1024) na_block(p, l, a - 512, lb);
                                else if (l < DEPTH - 1) ctx_block(p, l, a - 1024, lb);
                            }
                        } else {
                            for (int it = bid; it < 144 + 512 + 512 + 192; it += G) {
                                if (it < 144) ssm_a_item(p, l, it, lf);
                                else if (it < 656) wa_block(p, l, it - 144, lb);
                                else if (it < 1168) na_block(p, l, it - 656, lb);
                                else if (l < DEPTH - 1) ctx_block(p, l, it - 1168, lb);
                            }
                        }
                    }
                    GSYNC();
                    phase_ssm_scan(p);
                    GSYNC();
                    {
                        const int bid = BIDX, G = (int)gridDim.x;
                        if (G == 256) {
                            if (bid < 144) { if (l < DEPTH - 1 || (bid % 18) >= 2) ssm_b_item(p, l, bid, lds); ga_block(p, bid, lb); }
                            else { const int j = bid - 144; ga_block(p, 144 + j, lb); ga_block(p, 256 + j, lb); ga_block(p, 368 + j, lb); if (j < 32) ga_block(p, 480 + j, lb); }
                        } else {
                            for (int it = bid; it < 144 + 512; it += G) {
                                if (it < 144) { if (l < DEPTH - 1 || (it % 18) >= 2) ssm_b_item(p, l, it, lds); }
                                else ga_block(p, it - 144, lb);
                            }
                        }
                    }
                    GSYNC();
                }
            } else if (gi == 6) {
                phase_ada<false>(p, PIN(p, I_NFFN2) + l * 1024, l, 6, 7, lf);
                GSYNC();
            }
            bf16_t* H = (bf16_t*)(ws + OFF_H); bf16_t* BIG = (bf16_t*)(ws + OFF_BIG);
            const float* modl = (const float*)(ws + OFF_MOD) + (size_t)l * 9 * 9216;
            const bf16_t* A = H; const bf16_t* Bt = (const bf16_t*)(ws + OFF_WGU1); int K = 1024, M = MT, N = 1024;
            const bf16_t* A2 = H; const bf16_t* Bt2 = H; int M2 = 0, N2 = 0;
            EpiAny E; E.kind = 0; E.C = BIG; E.ldc = P1W; E.C2 = (bf16_t*)(ws + OFF_PT); E.ldc2 = MT; E.X = (float*)(ws + OFF_X); E.modl = modl; E.idx = 2; E.coef = 0.5f;
            E.P1 = BIG; E.bg = PIN(p, I_BGATE) + (size_t)l * 4096; E.Gb = H;
            if (gi == 0) { N = 5632; E.kind = 1; }
            if (gi == 1) { A = BIG; Bt = (const bf16_t*)(ws + OFF_WD1); K = DFF; E.kind = 2; }
            else if (gi == 2) { Bt = (const bf16_t*)(ws + OFF_WIN); N = 6144; A2 = (const bf16_t*)(ws + OFF_WIN) + (size_t)6144 * 1024; Bt2 = H; M2 = 1024; N2 = MT; }
            else if (gi == 3) { continue; }
            if (gi >= 4 && l == DEPTH - 1) M = ML;
            if (gi < 4) { }
            else if (gi == 4) { A = (const bf16_t*)(ws + OFF_Y); Bt = (const bf16_t*)(ws + OFF_WBR); E.kind = 3; }
            else if (gi == 5) { Bt = (const bf16_t*)(ws + OFF_WO); E.kind = 2; E.idx = 5; E.coef = 1.0f; }
            else if (gi == 6) { Bt = (const bf16_t*)(ws + OFF_WGU2); N = 5632; E.kind = 1; }
            else { A = BIG; Bt = (const bf16_t*)(ws + OFF_WD2); K = DFF; E.kind = 2; E.idx = 8; }
            run_gemm(lds, A, Bt, K, M, N, A2, Bt2, M2, N2, E);
            if (gridDim.x == 256) {
                if (gi == 4 && l < DEPTH - 1) convert_layer(p, l + 1, lf, 0, 976, 32);
                if (gi == 0 && l > 0) convert_layer(p, l, lf, 976, 1632, 48);
            } else {
                if (gi == 4 && l < DEPTH - 1) { __syncthreads(); convert_layer(p, l + 1, lf, 0, 976, 0); }
                if (gi == 0 && l > 0) { __syncthreads(); convert_layer(p, l, lf, 976, 1632, 0); }
            }
            GSYNC();
        }
    }
    phase_final(p);
}

extern "C" void kernel_launch(void* const* d_in, const int* in_sizes, int n_in, void* d_out, int out_size, void* d_ws, size_t ws_size, hipStream_t stream) {
    static int grid_blocks = 0;
    if (!grid_blocks) {
        if (hipFuncSetAttribute((const void*)hybrid_fwd, hipFuncAttributeMaxDynamicSharedMemorySize, LDS_BYTES) != hipSuccess) fprintf(stderr, "hipFuncSetAttribute failed\n");
        int dev = 0, cus = 0, per_cu = 0;
        hipGetDevice(&dev);
        hipDeviceGetAttribute(&cus, hipDeviceAttributeMultiprocessorCount, dev);
        hipOccupancyMaxActiveBlocksPerMultiprocessor(&per_cu, hybrid_fwd, 512, LDS_BYTES);
        if (per_cu < 1) per_cu = 1;
        if (per_cu > 1) per_cu = 1;
        grid_blocks = cus * per_cu;
        if (ws_size < WS_END) fprintf(stderr, "workspace too small: %zu < %zu\n", ws_size, (size_t)WS_END);
    }
    Params p{};
    for (int i = 0; i < 30; ++i) p.in[i] = (const float*)d_in[i];
    p.out = (float*)d_out; p.ws = (unsigned char*)d_ws;
    (void)hipMemsetAsync((unsigned char*)d_ws + OFF_BAR, 0, 16384, stream);
    void* args[] = {&p};
    hipError_t e = hipLaunchCooperativeKernel((void*)hybrid_fwd, dim3(grid_blocks), dim3(512), args, LDS_BYTES, stream);
    if (e != hipSuccess) fprintf(stderr, "cooperative launch failed: %s (grid %d)\n", hipGetErrorString(e), grid_blocks);
}
```

```cpp
#define WGM_IN 8
#define WGM_DN 2
#include <hip/hip_runtime.h>
#include <hip/hip_cooperative_groups.h>
#include <cstdio>
#include <cstdint>
namespace cg = cooperative_groups;

#define PG8_LAS __attribute__((address_space(3)))
typedef unsigned short bf16_t;
typedef short bf16x8 __attribute__((ext_vector_type(8)));
typedef short bf16x4 __attribute__((ext_vector_type(4)));
typedef float f32x4 __attribute__((ext_vector_type(4)));
typedef unsigned u32x4 __attribute__((ext_vector_type(4)));
constexpr int BM = 256, BK = 64, HALF = 128, HTB = HALF * BK * 2, NXCD = 8;
#ifndef WGM_GU
#define WGM_GU 4
#endif
#ifndef WGM_DN
#define WGM_DN 4
#endif
#ifndef WGM_OT
#define WGM_OT 4
#endif
#ifndef WGM_IN
#define WGM_IN 4
#endif

constexpr int DM = 1024, NBATCH = 8, SEQ = 2048, CTXL = 256, DFF = 2816, DEPTH = 4, NIN = 6920;
constexpr int ML = NBATCH * SEQ, MC = NBATCH * CTXL, MT = ML + MC;
constexpr int P1W = 6144;
constexpr float EPS = 1e-6f;
constexpr float LOG2E = 1.4426950408889634f;
constexpr int LDS_BYTES = 147456;

constexpr size_t SZ_WGU = (size_t)5632 * 1024 * 2, SZ_WD = (size_t)1024 * 2816 * 2, SZ_WIN = (size_t)7168 * 1024 * 2, SZ_WBR = (size_t)4 * 1024 * 256 * 2, SZ_WO = (size_t)1024 * 1024 * 2;
constexpr size_t OFF_WGU1 = 0, OFF_WD1 = OFF_WGU1 + SZ_WGU, OFF_WIN = OFF_WD1 + SZ_WD, OFF_WBR = OFF_WIN + SZ_WIN, OFF_WO = OFF_WBR + SZ_WBR,
                 OFF_WGU2 = OFF_WO + SZ_WO, OFF_WD2 = OFF_WGU2 + SZ_WGU, OFF_X = OFF_WD2 + SZ_WD;
constexpr size_t OFF_H = OFF_X + (size_t)MT * 1024 * 4, OFF_BIG = OFF_H + (size_t)MT * 1024 * 2, OFF_PT = OFF_BIG + (size_t)MT * P1W * 2,
                 OFF_BC = OFF_PT + (size_t)1024 * MT * 2, OFF_XBT = OFF_BC + (size_t)MT * 512 * 2, OFF_ST = OFF_XBT + (size_t)512 * MT * 2,
                 OFF_Y = OFF_ST + (size_t)NBATCH * 18 * 8 * 8192 * 4, OFF_MOD = OFF_Y + (size_t)MT * 1024 * 2, OFF_DT = OFF_MOD + (size_t)4 * 9 * 9216 * 4,
                 OFF_CUM = OFF_DT + (size_t)MT * 8 * 4, OFF_TOT = OFF_CUM + (size_t)MT * 8 * 4, OFF_BAR = OFF_TOT + (size_t)NBATCH * 18 * 8 * 4, OFF_SIN = OFF_BAR + 16384, OFF_ROPE = OFF_SIN + (size_t)NBATCH * 18 * 8 * 8192 * 2, WS_END = OFF_ROPE + (size_t)2048 * 64 * 4;
constexpr size_t OFF_G = OFF_PT;

__host__ __device__ __forceinline__ int lds_byte(int r, int c) { const int st = (r >> 4) * 2 + (c >> 5), rr = r & 15, cc = c & 31, ob = rr * 64 + cc * 2; return st * 1024 + (ob ^ (((ob >> 9) & 1) << 5)); }
__host__ __device__ __forceinline__ void stage_rc(int b, int& R, int& C) { const int st = b / 1024, sb = b % 1024, swz = sb ^ (((sb >> 9) & 1) << 5); R = (st >> 1) * 16 + swz / 64; C = (st & 1) * 32 + (swz % 64) / 2; }
__host__ __device__ __forceinline__ int perm32(int rho) { const int n = rho >> 4, i = rho & 15; return 8 * (i >> 2) + 4 * n + (i & 3); }

struct Unit { int pm, pn, k0, nk, split; };
struct Gemm { const bf16_t* A; const bf16_t* Bt; const bf16_t* A2; const bf16_t* Bt2; int M, N, K; };

struct StaticOrder {
    int nM, nN, nwg, G, c, KT, nM2, nN2, nwg2, wgm;
    __host__ __device__ __forceinline__ void init(int M, int N, int K, int G_, int c_, int M2, int N2) {
        nM = M / BM; nN = N / BM; nwg = nM * nN; G = G_; c = c_; KT = K / BK; nM2 = M2 / BM; nN2 = N2 / BM; nwg2 = nM2 * nN2;
        wgm = N == 5632 ? WGM_GU : (K == DFF ? WGM_DN : (N == 6144 ? WGM_IN : WGM_OT));
    }
    __host__ __device__ __forceinline__ static void tile(int wgid, int nM_, int nN_, int nwg_, int WGM, Unit& u) {
        { const int q = nwg_ / NXCD, r = nwg_ % NXCD, xcd = wgid % NXCD, off = wgid / NXCD; wgid = (xcd < r ? xcd * (q + 1) : r * (q + 1) + (xcd - r) * q) + off; }
        const int nig = WGM * nN_, gid = wgid / nig, fm = gid * WGM, gsz = (nM_ - fm) < WGM ? (nM_ - fm) : WGM;
        u.pm = fm + ((wgid % nig) % gsz); u.pn = (wgid % nig) / gsz;
    }
    __host__ __device__ __forceinline__ bool next(int i, Unit& u) const {
        const long L = (long)i * G + c;
        u.k0 = 0; u.nk = KT;
        if (L < nwg) { tile((int)L, nM, nN, nwg, wgm, u); u.split = 0; return true; }
        if (L - nwg < nwg2) { tile((int)(L - nwg), nM2, nN2, nwg2, wgm, u); u.split = 1; return true; }
        return false;
    }
    __device__ __forceinline__ void a_ready(const Unit&) const {}
    __device__ __forceinline__ void done(const Unit&) const {}
};

__device__ __forceinline__ int opq_i(int v) { asm volatile("" : "+v"(v)); return __builtin_amdgcn_readfirstlane(v); }
template <class T> __device__ __forceinline__ T* opq_p(T* ptr) {
    unsigned long long a = (unsigned long long)ptr; unsigned lo = (unsigned)a, hi = (unsigned)(a >> 32);
    asm volatile("" : "+v"(lo), "+v"(hi));
    lo = (unsigned)__builtin_amdgcn_readfirstlane((int)lo); hi = (unsigned)__builtin_amdgcn_readfirstlane((int)hi);
    return (T*)(((unsigned long long)hi << 32) | lo);
}
__device__ __forceinline__ int tid_opaque() { int t = threadIdx.x; asm volatile("" : "+v"(t)); return t; }
__device__ __forceinline__ int bid_opaque() { return opq_i((int)blockIdx.x); }
#define TIDX tid_opaque()
#define BIDX bid_opaque()
__device__ __forceinline__ float bf2f(bf16_t v) { return __uint_as_float(((unsigned)v) << 16); }
__device__ __forceinline__ unsigned pk2(float lo, float hi);
__device__ __forceinline__ bf16_t f2bf(float x) { return (bf16_t)(pk2(x, x) & 0xffffu); }
typedef float f32x2v __attribute__((ext_vector_type(2)));
typedef __bf16 bf16x2v __attribute__((ext_vector_type(2)));
__device__ __forceinline__ unsigned pk2(float lo, float hi) { const f32x2v v = {lo, hi}; const bf16x2v b = __builtin_convertvector(v, bf16x2v); return __builtin_bit_cast(unsigned, b); }
__device__ __forceinline__ float siluf(float x) { return x * __builtin_amdgcn_rcpf(1.f + __expf(-x)); }
__device__ __forceinline__ float sigmf(float x) { return __builtin_amdgcn_rcpf(1.f + __expf(-x)); }
__device__ __forceinline__ float ex2(float x) { return __builtin_amdgcn_exp2f(x); }

typedef unsigned u32x2 __attribute__((ext_vector_type(2)));
typedef __attribute__((address_space(1))) const u32x2 gc_uint2;
typedef __attribute__((address_space(1))) const f32x4 gc_float4;
typedef __attribute__((address_space(1))) f32x4 g_float4;
typedef __attribute__((address_space(1))) u32x2 g_uint2;
struct EpiStore {
    static constexpr bool PERM = false, AFTER_DRAIN = false;
    bf16_t* C; long ldc;
    __device__ __forceinline__ void operator()(const f32x4 (&acc)[2][2][4][2], const Unit& u, int wr, int wc, int fr, int fq) const {
#pragma unroll
        for (int ai = 0; ai < 2; ++ai)
#pragma unroll
            for (int m = 0; m < 4; ++m) {
                const long r = 256 * u.pm + 128 * ai + 64 * wr + 16 * m + fr;
#pragma unroll
                for (int bj = 0; bj < 2; ++bj)
#pragma unroll
                    for (int n = 0; n < 2; ++n) {
                        const int c = 256 * u.pn + 128 * bj + 32 * wc + 16 * n + 4 * fq;
                        const f32x4 v = acc[ai][bj][m][n];
                        u32x2 o; o.x = pk2(v[0], v[1]); o.y = pk2(v[2], v[3]);
                        *(g_uint2*)(C + r * ldc + c) = o;
                    }
            }
    }
};
struct EpiGateUp {
    static constexpr bool PERM = false, AFTER_DRAIN = false;
    bf16_t* C;
    __device__ __forceinline__ void operator()(const f32x4 (&acc)[2][2][4][2], const Unit& u, int wr, int wc, int fr, int fq) const {
#pragma unroll
        for (int ai = 0; ai < 2; ++ai)
#pragma unroll
            for (int m = 0; m < 4; ++m) {
                const long r = 256 * u.pm + 128 * ai + 64 * wr + 16 * m + fr;
#pragma unroll
                for (int n = 0; n < 2; ++n) {
                    const int c = 128 * u.pn + 32 * wc + 16 * n + 4 * fq;
                    const f32x4 g = acc[ai][0][m][n], up = acc[ai][1][m][n];
                    u32x2 o; o.x = pk2(siluf(g[0]) * up[0], siluf(g[1]) * up[1]); o.y = pk2(siluf(g[2]) * up[2], siluf(g[3]) * up[3]);
                    *(g_uint2*)(C + r * DFF + c) = o;
                }
            }
    }
};
struct EpiResid {
    static constexpr bool PERM = false, AFTER_DRAIN = false;
    float* X; const float* modl; int idx; float coef;
    __device__ __forceinline__ void operator()(const f32x4 (&acc)[2][2][4][2], const Unit& u, int wr, int wc, int fr, int fq) const {
        const int bi = u.pm < 64 ? (u.pm >> 3) : 8;
        const float* mv = modl + bi * 9216 + idx * 1024;
#pragma unroll
        for (int bj = 0; bj < 2; ++bj)
#pragma unroll
            for (int n = 0; n < 2; ++n) {
                const int c = 256 * u.pn + 128 * bj + 32 * wc + 16 * n + 4 * fq;
                f32x4 mm = *(gc_float4*)(mv + c);
                mm.x *= coef; mm.y *= coef; mm.z *= coef; mm.w *= coef;
                f32x4 xv[8];
#pragma unroll
                for (int ai = 0; ai < 2; ++ai)
#pragma unroll
                    for (int m = 0; m < 4; ++m) xv[ai * 4 + m] = *(gc_float4*)(X + (long)(256 * u.pm + 128 * ai + 64 * wr + 16 * m + fr) * 1024 + c);
#pragma unroll
                for (int ai = 0; ai < 2; ++ai)
#pragma unroll
                    for (int m = 0; m < 4; ++m) {
                        const f32x4 v = acc[ai][bj][m][n];
                        f32x4 x = xv[ai * 4 + m];
                        x.x += mm.x * v[0]; x.y += mm.y * v[1]; x.z += mm.z * v[2]; x.w += mm.w * v[3];
                        *(g_float4*)(X + (long)(256 * u.pm + 128 * ai + 64 * wr + 16 * m + fr) * 1024 + c) = x;
                    }
            }
    }
};
struct EpiBranch {
    static constexpr bool PERM = false, AFTER_DRAIN = false;
    const bf16_t* P1; const float* bg; bf16_t* Gb;
    __device__ __forceinline__ static float e_of(float x) { return fminf(__expf(-x), 1e20f); }
    __device__ __forceinline__ void hook(f32x4 (&acc)[2][2][4][2], const Unit& u, int wr, int wc, int fr, int fq, int kb) const {
        asm volatile("" : "+v"(fr), "+v"(fq));
#pragma unroll
        for (int bj = 0; bj < 2; ++bj)
#pragma unroll
            for (int n = 0; n < 2; ++n) {
                const int c = 256 * u.pn + 128 * bj + 32 * wc + 16 * n + 4 * fq;
                const f32x4 b0 = *(gc_float4*)(bg + kb * 1024 + c), b1 = *(gc_float4*)(bg + (kb + 1) * 1024 + c);
                u32x2 g0[8], g1[8];
#pragma unroll
                for (int ai = 0; ai < 2; ++ai)
#pragma unroll
                    for (int m = 0; m < 4; ++m) {
                        const bf16_t* gp = P1 + (long)(256 * u.pm + 128 * ai + 64 * wr + 16 * m + fr) * P1W + 2048 + kb * 1024 + c;
                        g0[ai * 4 + m] = *(gc_uint2*)gp; g1[ai * 4 + m] = *(gc_uint2*)(gp + 1024);
                    }
#pragma unroll
                for (int ai = 0; ai < 2; ++ai)
#pragma unroll
                    for (int m = 0; m < 4; ++m) {
                        const u32x2 ga = g0[ai * 4 + m], gb = g1[ai * 4 + m];
                        f32x4 v = acc[ai][bj][m][n];
                        v[0] *= (1.f + e_of(__uint_as_float(gb.x << 16) + b1.x)) * __builtin_amdgcn_rcpf(1.f + e_of(__uint_as_float(ga.x << 16) + b0.x));
                        v[1] *= (1.f + e_of(__uint_as_float(gb.x & 0xffff0000u) + b1.y)) * __builtin_amdgcn_rcpf(1.f + e_of(__uint_as_float(ga.x & 0xffff0000u) + b0.y));
                        v[2] *= (1.f + e_of(__uint_as_float(gb.y << 16) + b1.z)) * __builtin_amdgcn_rcpf(1.f + e_of(__uint_as_float(ga.y << 16) + b0.z));
                        v[3] *= (1.f + e_of(__uint_as_float(gb.y & 0xffff0000u) + b1.w)) * __builtin_amdgcn_rcpf(1.f + e_of(__uint_as_float(ga.y & 0xffff0000u) + b0.w));
                        acc[ai][bj][m][n] = v;
                    }
            }
    }
    __device__ __forceinline__ void operator()(const f32x4 (&acc)[2][2][4][2], const Unit& u, int wr, int wc, int fr, int fq) const {
#pragma unroll
        for (int bj = 0; bj < 2; ++bj)
#pragma unroll
            for (int n = 0; n < 2; ++n) {
                const int c = 256 * u.pn + 128 * bj + 32 * wc + 16 * n + 4 * fq;
                const f32x4 bb = *(gc_float4*)(bg + 3 * 1024 + c);
                u32x2 g3[8];
#pragma unroll
                for (int ai = 0; ai < 2; ++ai)
#pragma unroll
                    for (int m = 0; m < 4; ++m) g3[ai * 4 + m] = *(gc_uint2*)(P1 + (long)(256 * u.pm + 128 * ai + 64 * wr + 16 * m + fr) * P1W + 2048 + 3 * 1024 + c);
#pragma unroll
                for (int ai = 0; ai < 2; ++ai)
#pragma unroll
                    for (int m = 0; m < 4; ++m) {
                        const long r = 256 * u.pm + 128 * ai + 64 * wr + 16 * m + fr;
                        const f32x4 v = acc[ai][bj][m][n];
                        const u32x2 gp = g3[ai * 4 + m];
                        const float o0 = v[0] * __builtin_amdgcn_rcpf(1.f + e_of(__uint_as_float(gp.x << 16) + bb.x));
                        const float o1 = v[1] * __builtin_amdgcn_rcpf(1.f + e_of(__uint_as_float(gp.x & 0xffff0000u) + bb.y));
                        const float o2 = v[2] * __builtin_amdgcn_rcpf(1.f + e_of(__uint_as_float(gp.y << 16) + bb.z));
                        const float o3 = v[3] * __builtin_amdgcn_rcpf(1.f + e_of(__uint_as_float(gp.y & 0xffff0000u) + bb.w));
                        u32x2 ob; ob.x = pk2(o0, o1); ob.y = pk2(o2, o3); *(g_uint2*)(Gb + r * 1024 + c) = ob;
                    }
            }
    }
};

template <class Epi, class Sched, bool ALIGN_EPI = false, bool SP2 = false>
__device__ __forceinline__ void gemm_phase(PG8_LAS unsigned char* lds, const Gemm g, const Sched& S, const Epi& E) {
    int tid_ = threadIdx.x; asm volatile("" : "+v"(tid_));
    const int tid = tid_, wid = __builtin_amdgcn_readfirstlane(tid >> 6), lane = tid & 63, wr = wid >> 2, wc = wid & 3, fr = lane & 15, fq = lane >> 4;
    const int K = g.K;
    unsigned voffA[2], voffB[2];
#pragma unroll
    for (int i = 0; i < 2; ++i) { int R, C; stage_rc(tid * 16 + i * 8192, R, C); const int Rb = Epi::PERM ? ((R & ~31) + perm32(R & 31)) : R;
        voffA[i] = (unsigned)(R * K + C) * 2u; voffB[i] = (unsigned)(Rb * K + C) * 2u; }
    const size_t kstep = (size_t)(BK * 2);
    const size_t hstep = (size_t)HALF * K * 2;
    const size_t tstep = 2 * hstep;
    const unsigned ldsw = (unsigned)wid * 1024u;
    const int aoff = lds_byte(wr * 64 + fr, fq * 8), boff = lds_byte(wc * 32 + fr, fq * 8);
#define PG8_SA(b, h) (((b) * 2 + (h)) * HTB)
#define PG8_SB(b, h) ((4 + (b) * 2 + (h)) * HTB)
#define PG8_STAGE(bufoff, gbase, voff) do { _Pragma("unroll") for (int _i = 0; _i < 2; ++_i) \
        __builtin_amdgcn_global_load_lds((const unsigned*)((const char*)(gbase) + (voff)[_i]), (PG8_LAS unsigned*)(lds + (bufoff) + ldsw + _i * 8192), 16, 0, 0); } while (0)
#define PG8_LDA(dst, b, h) do { _Pragma("unroll") for (int m = 0; m < 4; ++m) _Pragma("unroll") for (int k = 0; k < 2; ++k) dst[m][k] = *(const PG8_LAS bf16x8*)(lds + PG8_SA(b, h) + aoff + m * 2048 + k * 1024); } while (0)
#define PG8_LDB(dst, b, h) do { _Pragma("unroll") for (int n = 0; n < 2; ++n) _Pragma("unroll") for (int k = 0; k < 2; ++k) dst[n][k] = *(const PG8_LAS bf16x8*)(lds + PG8_SB(b, h) + boff + n * 2048 + k * 1024); } while (0)
#define PG8_MMA(ai, bj, At, Bt) do { __builtin_amdgcn_s_setprio(1); _Pragma("unroll") for (int m = 0; m < 4; ++m) _Pragma("unroll") for (int n = 0; n < 2; ++n) _Pragma("unroll") for (int k = 0; k < 2; ++k) \
        acc[ai][bj][m][n] = __builtin_amdgcn_mfma_f32_16x16x32_bf16(Bt[n][k], At[m][k], acc[ai][bj][m][n], 0, 0, 0); __builtin_amdgcn_s_setprio(0); } while (0)
#define PG8_WAIT_V(n) asm volatile("s_waitcnt vmcnt(" #n ")" ::: "memory")
#define PG8_WAIT_L(n) asm volatile("s_waitcnt lgkmcnt(" #n ")" ::: "memory")
#define PG8_BAR __builtin_amdgcn_s_barrier()
#define PG8_SCHED __builtin_amdgcn_sched_barrier(0)
    Unit cur, nxt; int ui = 0;
    if (!S.next(0, cur)) return;
    f32x4 acc[2][2][4][2];
#pragma unroll
    for (int a = 0; a < 2; ++a)
#pragma unroll
        for (int b = 0; b < 2; ++b)
#pragma unroll
            for (int m = 0; m < 4; ++m)
#pragma unroll
                for (int n = 0; n < 2; ++n) acc[a][b][m][n] = (f32x4){0.f, 0.f, 0.f, 0.f};
    bf16x8 At[4][2], B0[2][2], B1[2][2];
    const char* cA = (const char*)(cur.split ? g.A2 : g.A) + (size_t)cur.pm * tstep + (size_t)cur.k0 * kstep; const char* cB = (const char*)(cur.split ? g.Bt2 : g.Bt) + (size_t)cur.pn * tstep + (size_t)cur.k0 * kstep;
    S.a_ready(cur);
    if constexpr (SP2) {
        PG8_STAGE(PG8_SB(0, 0), cB, voffB); PG8_STAGE(PG8_SB(0, 1), cB + hstep, voffB); PG8_STAGE(PG8_SA(0, 0), cA, voffA); PG8_STAGE(PG8_SA(0, 1), cA + hstep, voffA);
        if (wr == 1) PG8_BAR;
        PG8_WAIT_V(2); PG8_BAR;
        PG8_STAGE(PG8_SB(1, 0), cB + kstep, voffB); PG8_STAGE(PG8_SA(1, 0), cA + kstep, voffA); PG8_STAGE(PG8_SB(1, 1), cB + hstep + kstep, voffB);
        PG8_WAIT_V(6); PG8_BAR;
    } else {
        PG8_STAGE(PG8_SB(0, 0), cB, voffB); PG8_STAGE(PG8_SA(0, 0), cA, voffA); PG8_STAGE(PG8_SB(0, 1), cB + hstep, voffB); PG8_STAGE(PG8_SA(0, 1), cA + hstep, voffA);
        if (wr == 1) PG8_BAR;
        PG8_WAIT_V(4); PG8_BAR;
        PG8_STAGE(PG8_SB(1, 0), cB + kstep, voffB); PG8_STAGE(PG8_SA(1, 0), cA + kstep, voffA); PG8_STAGE(PG8_SB(1, 1), cB + hstep + kstep, voffB);
        PG8_WAIT_V(6); PG8_BAR;
    }
    for (;;) {
        const bool has_next = S.next(ui + 1, nxt);
        const char* nA = has_next ? (const char*)(nxt.split ? g.A2 : g.A) + (size_t)nxt.pm * tstep + (size_t)nxt.k0 * kstep : cA; const char* nB = has_next ? (const char*)(nxt.split ? g.Bt2 : g.Bt) + (size_t)nxt.pn * tstep + (size_t)nxt.k0 * kstep : cB;
        const int nt = cur.nk;
        for (int t = 0; t < nt; t += 2) {
            const bool last = (t == nt - 2);
            const char* a1 = cA + (size_t)(t + 1) * kstep;
            const char* a2 = last ? nA : cA + (size_t)(t + 2) * kstep; const char* b2 = last ? nB : cB + (size_t)(t + 2) * kstep;
            const char* a3 = a2 + kstep; const char* b3 = b2 + kstep;
            if (last && has_next) S.a_ready(nxt);
            if constexpr (SP2) {
            PG8_LDB(B0, 0, 0); PG8_LDB(B1, 0, 1); PG8_SCHED; PG8_LDA(At, 0, 0); PG8_STAGE(PG8_SA(1, 1), a1 + hstep, voffA);
            PG8_WAIT_V(8); PG8_WAIT_L(0); PG8_BAR; PG8_MMA(0, 0, At, B0); PG8_MMA(0, 1, At, B1); PG8_BAR; PG8_SCHED;
            PG8_LDA(At, 0, 1); PG8_STAGE(PG8_SB(0, 0), b2, voffB); PG8_STAGE(PG8_SB(0, 1), b2 + hstep, voffB); PG8_STAGE(PG8_SA(0, 0), a2, voffA);
            PG8_WAIT_V(8); PG8_WAIT_L(0); PG8_BAR; PG8_MMA(1, 0, At, B0); PG8_MMA(1, 1, At, B1); PG8_BAR; PG8_SCHED;
            PG8_LDB(B0, 1, 0); PG8_LDB(B1, 1, 1); PG8_SCHED; PG8_LDA(At, 1, 0); PG8_STAGE(PG8_SA(0, 1), a2 + hstep, voffA);
            PG8_WAIT_V(8); PG8_WAIT_L(0); PG8_BAR; PG8_MMA(0, 0, At, B0); PG8_MMA(0, 1, At, B1); PG8_BAR; PG8_SCHED;
            PG8_LDA(At, 1, 1); PG8_STAGE(PG8_SB(1, 0), b3, voffB); PG8_STAGE(PG8_SB(1, 1), b3 + hstep, voffB); PG8_STAGE(PG8_SA(1, 0), a3, voffA);
            PG8_WAIT_V(8); PG8_WAIT_L(0); PG8_BAR; PG8_MMA(1, 0, At, B0); PG8_MMA(1, 1, At, B1); PG8_BAR; PG8_SCHED;
            } else {
            PG8_LDB(B0, 0, 0); PG8_SCHED; PG8_LDA(At, 0, 0); PG8_STAGE(PG8_SA(1, 1), a1 + hstep, voffA);
            PG8_WAIT_L(8); PG8_BAR; PG8_WAIT_L(0); PG8_MMA(0, 0, At, B0); PG8_BAR; PG8_SCHED;
            PG8_LDB(B1, 0, 1); PG8_STAGE(PG8_SB(0, 0), b2, voffB);
            PG8_BAR; PG8_WAIT_L(0); PG8_MMA(0, 1, At, B1); PG8_BAR;
            PG8_LDA(At, 0, 1); PG8_STAGE(PG8_SA(0, 0), a2, voffA);
            PG8_BAR; PG8_WAIT_L(0); PG8_MMA(1, 0, At, B0); PG8_BAR; PG8_SCHED;
            PG8_STAGE(PG8_SB(0, 1), b2 + hstep, voffB);
            PG8_WAIT_V(6); PG8_BAR; PG8_MMA(1, 1, At, B1); PG8_BAR;
            PG8_LDB(B0, 1, 0); PG8_SCHED; PG8_LDA(At, 1, 0); PG8_STAGE(PG8_SA(0, 1), a2 + hstep, voffA);
            PG8_WAIT_L(8); PG8_BAR; PG8_WAIT_L(0); PG8_MMA(0, 0, At, B0); PG8_BAR; PG8_SCHED;
            PG8_LDB(B1, 1, 1); PG8_STAGE(PG8_SB(1, 0), b3, voffB);
            PG8_BAR; PG8_WAIT_L(0); PG8_MMA(0, 1, At, B1); PG8_BAR;
            PG8_LDA(At, 1, 1); PG8_STAGE(PG8_SA(1, 0), a3, voffA);
            PG8_BAR; PG8_WAIT_L(0); PG8_MMA(1, 0, At, B0); PG8_BAR; PG8_SCHED;
            PG8_STAGE(PG8_SB(1, 1), b3 + hstep, voffB);
            PG8_WAIT_V(6); PG8_BAR; PG8_MMA(1, 1, At, B1); PG8_BAR;
            }
            if (E.hook_on() && ((t + 2) & 3) == 0 && t + 2 < nt) E.hook(acc, cur, wr, wc, fr, fq, ((t + 2) >> 2) - 1);
        }
        if constexpr (ALIGN_EPI) { if (wr == 0) PG8_BAR; }
        if constexpr (!Epi::AFTER_DRAIN) { E(acc, cur, wr, wc, fr, fq); S.done(cur); }
        if (!has_next) break;
#pragma unroll
        for (int a = 0; a < 2; ++a)
#pragma unroll
            for (int b = 0; b < 2; ++b)
#pragma unroll
                for (int m = 0; m < 4; ++m)
#pragma unroll
                    for (int n = 0; n < 2; ++n) acc[a][b][m][n] = (f32x4){0.f, 0.f, 0.f, 0.f};
        cur = nxt; cA = nA; cB = nB; ++ui;
        if constexpr (ALIGN_EPI) { if (wr == 1) PG8_BAR; }
    }
    PG8_WAIT_V(0);
    if constexpr (!ALIGN_EPI) { if (wr == 0) PG8_BAR; }
    PG8_BAR;
    if constexpr (Epi::AFTER_DRAIN) { E.fused(acc, cur, wr, wc, fr, fq, lds, wid, lane); S.done(cur); }
#undef PG8_SA
#undef PG8_SB
#undef PG8_STAGE
#undef PG8_LDA
#undef PG8_LDB
#undef PG8_MMA
#undef PG8_WAIT_V
#undef PG8_WAIT_L
#undef PG8_BAR
#undef PG8_SCHED
}

#define MFMA32(a, b, c) __builtin_amdgcn_mfma_f32_16x16x32_bf16((a), (b), (c), 0, 0, 0)
#define MFMA16(a, b, c) __builtin_amdgcn_mfma_f32_16x16x16bf16_1k((a), (b), (c), 0, 0, 0)

struct Params { const float* in[30]; float* out; unsigned char* ws; };
__device__ __forceinline__ unsigned char* ws_load() { unsigned char* const* tab = (unsigned char* const*)opq_p((const void*)__builtin_amdgcn_kernarg_segment_ptr()); return opq_p(tab[31]); }
#define WSP(p) ws_load()
__device__ __forceinline__ const float* pin_load(int i) { const float* const* tab = (const float* const*)opq_p((const void*)__builtin_amdgcn_kernarg_segment_ptr()); return opq_p(tab[i]); }
#define PIN(p, i) pin_load(i)
enum { I_X = 0, I_C, I_CTX, I_CCTX, I_WMOD, I_BMOD, I_NFFN1, I_F1G, I_F1U, I_F1D, I_NMIX, I_WIN, I_BGATE, I_SINK, I_RPB, I_QNQ, I_QNK,
       I_CONVW, I_CONVB, I_DTB, I_ALOG, I_SSMD, I_SSMN, I_WBR, I_WOUT, I_NFFN2, I_F2G, I_F2U, I_F2D, I_FNORM };

__device__ __forceinline__ void win_map(int n, int& r1, int& r2) {
    r1 = -1; r2 = -1;
    if (n < 256) r1 = n;
    else if (n < 384) r1 = 256 + (n - 256);
    else if (n < 512) r2 = n - 384;
    else if (n < 768) r1 = 384 + (n - 512);
    else if (n < 1024) r1 = 640 + (n - 768);
    else if (n < 1280) r2 = 128 + (n - 1024);
    else if (n < 1536) r1 = 896 + (n - 1280);
    else if (n < 1664) r1 = 1152 + (n - 1536);
    else if (n < 1792) r2 = 384 + (n - 1664);
    else if (n < 2048) r1 = 1280 + (n - 1792);
    else if (n < 2304) r2 = 512 + (n - 2048);
    else if (n < 2560) { r1 = 1536 + (n - 2304); r2 = 768 + (n - 2304); }
    else if (n < 2816) r1 = 1792 + (n - 2560);
    else if (n < 2824) { }
    else r1 = 2048 + (n - 2824);
    if (r2 >= 0) r2 += 6144;
}
__device__ __forceinline__ void convert_tile4(const float* __restrict__ src, int N, int ntn, int tk, int tn0, int kind, bf16_t* __restrict__ dst, int ldd, PG8_LAS float* tile) {
    const int tid = TIDX;
    const int kk = tid >> 3, nn = (tid & 7) * 8, k0 = tk * 64;
    float4 va[4], vb[4];
#pragma unroll
    for (int j = 0; j < 4; ++j) {
        const int n0 = (tn0 + j) * 64;
        if (tn0 + j < ntn && n0 + nn + 8 <= N) { const float* sp = src + (size_t)(k0 + kk) * N + n0 + nn; va[j] = *(const float4*)sp; vb[j] = *(const float4*)(sp + 4); }
        else { va[j] = make_float4(0.f, 0.f, 0.f, 0.f); vb[j] = va[j]; }
    }
#pragma unroll
    for (int j = 0; j < 4; ++j) {
        PG8_LAS float* t = tile + j * (64 * 65) + kk * 65 + nn;
        t[0] = va[j].x; t[1] = va[j].y; t[2] = va[j].z; t[3] = va[j].w; t[4] = vb[j].x; t[5] = vb[j].y; t[6] = vb[j].z; t[7] = vb[j].w;
    }
    __syncthreads();
    const int nr = tid >> 3, kc = (tid & 7) * 8;
#pragma unroll
    for (int j = 0; j < 4; ++j) {
        const int n = (tn0 + j) * 64 + nr;
        if (tn0 + j < ntn && n < N) {
            const PG8_LAS float* t = tile + j * (64 * 65) + nr;
            uint4 o;
            o.x = pk2(t[(kc + 0) * 65], t[(kc + 1) * 65]); o.y = pk2(t[(kc + 2) * 65], t[(kc + 3) * 65]);
            o.z = pk2(t[(kc + 4) * 65], t[(kc + 5) * 65]); o.w = pk2(t[(kc + 6) * 65], t[(kc + 7) * 65]);
            int r1 = -1, r2 = -1;
            if (kind == 0) r1 = n; else if (kind == 1) r1 = (n >> 7) * 256 + (n & 127); else if (kind == 2) r1 = (n >> 7) * 256 + 128 + (n & 127); else win_map(n, r1, r2);
            if (r1 >= 0) *(uint4*)(dst + (size_t)r1 * ldd + k0 + kc) = o;
            if (r2 >= 0) *(uint4*)(dst + (size_t)r2 * ldd + k0 + kc) = o;
        }
    }
    __syncthreads();
}
__device__ __forceinline__ void convert_layer(const Params& p, int l, PG8_LAS float* tile, int lo = 0, int hi = 1632, int c0 = 0) {
    unsigned char* ws = WSP(p);
    const int bid = BIDX;
    if (bid < c0) return;
    for (int it0 = lo + (bid - c0); it0 < hi; it0 += (int)gridDim.x - c0) {
        int it = it0;
        if (it < 176) convert_tile4(PIN(p, I_F1G) + (size_t)l * 1024 * 2816, 2816, 44, it / 11, (it % 11) * 4, 1, (bf16_t*)(ws + OFF_WGU1), 1024, tile);
        else if (it < 352) { it -= 176; convert_tile4(PIN(p, I_F1U) + (size_t)l * 1024 * 2816, 2816, 44, it / 11, (it % 11) * 4, 2, (bf16_t*)(ws + OFF_WGU1), 1024, tile); }
        else if (it < 528) { it -= 352; convert_tile4(PIN(p, I_F1D) + (size_t)l * 2816 * 1024, 1024, 16, it >> 2, (it & 3) * 4, 0, (bf16_t*)(ws + OFF_WD1), 2816, tile); }
        else if (it < 976) { it -= 528; convert_tile4(PIN(p, I_WIN) + (size_t)l * 1024 * NIN, NIN, 109, it / 28, (it % 28) * 4, 3, (bf16_t*)(ws + OFF_WIN), 1024, tile); }
        else if (it < 1040) { it -= 976; const int kb = it >> 4, r = it & 15; convert_tile4(PIN(p, I_WBR) + (size_t)(l * 4 + kb) * 256 * 1024, 1024, 16, r >> 2, (r & 3) * 4, 0, (bf16_t*)(ws + OFF_WBR) + (size_t)kb * 256, 1024, tile); }
        else if (it < 1104) { it -= 1040; convert_tile4(PIN(p, I_WOUT) + (size_t)l * 1024 * 1024, 1024, 16, it >> 2, (it & 3) * 4, 0, (bf16_t*)(ws + OFF_WO), 1024, tile); }
        else if (it < 1280) { it -= 1104; convert_tile4(PIN(p, I_F2G) + (size_t)l * 1024 * 2816, 2816, 44, it / 11, (it % 11) * 4, 1, (bf16_t*)(ws + OFF_WGU2), 1024, tile); }
        else if (it < 1456) { it -= 1280; convert_tile4(PIN(p, I_F2U) + (size_t)l * 1024 * 2816, 2816, 44, it / 11, (it % 11) * 4, 2, (bf16_t*)(ws + OFF_WGU2), 1024, tile); }
        else { it -= 1456; convert_tile4(PIN(p, I_F2D) + (size_t)l * 2816 * 1024, 1024, 16, it >> 2, (it & 3) * 4, 0, (bf16_t*)(ws + OFF_WD2), 2816, tile); }
    }
}

__device__ __forceinline__ void phase_mod(const Params& p, PG8_LAS float* lf) {
    const int tid = TIDX;
    PG8_LAS float* sA = lf;
    PG8_LAS float* red = lf + 9216;
    for (int i = tid; i < 9216; i += 512) { const int bi = i >> 10, k = i & 1023; const float v = bi < 8 ? PIN(p, I_C)[bi * 1024 + k] : PIN(p, I_CCTX)[k]; sA[i] = siluf(v); }
    __syncthreads();
    float* MOD = (float*)(WSP(p) + OFF_MOD);
    for (int it = BIDX; it < 4 * 144; it += gridDim.x) {
        const int l = it / 144, cb = it % 144, cl = tid & 63, kp = tid >> 6, col = cb * 64 + cl;
        const float* w = PIN(p, I_WMOD) + ((size_t)l * 1024 + kp * 128) * 9216 + col;
        float a0 = 0, a1 = 0, a2 = 0, a3 = 0, a4 = 0, a5 = 0, a6 = 0, a7 = 0, a8 = 0;
        for (int k = 0; k < 128; ++k) {
            const float wv = w[(size_t)k * 9216]; const int kk = kp * 128 + k;
            a0 += sA[kk] * wv; a1 += sA[1024 + kk] * wv; a2 += sA[2048 + kk] * wv; a3 += sA[3072 + kk] * wv; a4 += sA[4096 + kk] * wv;
            a5 += sA[5120 + kk] * wv; a6 += sA[6144 + kk] * wv; a7 += sA[7168 + kk] * wv; a8 += sA[8192 + kk] * wv;
        }
        red[(kp * 9 + 0) * 64 + cl] = a0; red[(kp * 9 + 1) * 64 + cl] = a1; red[(kp * 9 + 2) * 64 + cl] = a2; red[(kp * 9 + 3) * 64 + cl] = a3; red[(kp * 9 + 4) * 64 + cl] = a4;
        red[(kp * 9 + 5) * 64 + cl] = a5; red[(kp * 9 + 6) * 64 + cl] = a6; red[(kp * 9 + 7) * 64 + cl] = a7; red[(kp * 9 + 8) * 64 + cl] = a8;
        __syncthreads();
        for (int o = tid; o < 576; o += 512) {
            const int bi = o >> 6, cc = o & 63; float s = 0.f;
#pragma unroll
            for (int q = 0; q < 8; ++q) s += red[(q * 9 + bi) * 64 + cc];
            MOD[(size_t)(l * 9 + bi) * 9216 + cb * 64 + cc] = s + PIN(p, I_BMOD)[l * 9216 + cb * 64 + cc];
        }
        __syncthreads();
    }
}
__device__ __forceinline__ void phase_copy_x(const Params& p) {
    float4* X = (float4*)(WSP(p) + OFF_X);
    const float4* xs = (const float4*)PIN(p, I_X); const float4* cs = (const float4*)PIN(p, I_CTX);
    const size_t nl = (size_t)ML * 256, nc = (size_t)MC * 256, stride = (size_t)gridDim.x * 512;
    for (size_t i = (size_t)BIDX * 512 + TIDX; i < nl + nc; i += stride) X[i] = i < nl ? xs[i] : cs[i - nl];
}

template <bool WITH_DT>
__device__ __forceinline__ void phase_ada(const Params& p, const float* __restrict__ gain, int l, int ishift, int iscale, PG8_LAS float* lf) {
    unsigned char* ws = WSP(p);
    const float* __restrict__ X = (const float*)(ws + OFF_X); bf16_t* __restrict__ H = (bf16_t*)(ws + OFF_H);
    const float* __restrict__ modl = (const float*)(ws + OFF_MOD) + (size_t)l * 9 * 9216;
    const int tid = TIDX, lane = tid & 63, gw = BIDX * 8 + (tid >> 6), nw = gridDim.x * 8;
    if constexpr (WITH_DT) {
        const float* wdt = PIN(p, I_WIN) + (size_t)l * 1024 * NIN + 2816;
        for (int i = tid; i < 8192; i += 512) { const int k = i >> 3, j = i & 7; lf[j * 1024 + k] = wdt[(size_t)k * NIN + j]; }
        __syncthreads();
    }
    float4 gv[4];
#pragma unroll
    for (int i = 0; i < 4; ++i) gv[i] = *(const float4*)(gain + i * 256 + lane * 4);
    for (int row0 = gw; row0 < MT / 2; row0 += nw) {
        float4 v[2][4], sv[2][4], hv[2][4]; float ss[2] = {0.f, 0.f};
#pragma unroll
        for (int q = 0; q < 2; ++q) {
            const int row = row0 + q * (MT / 2);
            const int bi = row < ML ? (row >> 11) : 8;
            const float* xr = X + (size_t)row * 1024;
            const float* sh = modl + bi * 9216 + ishift * 1024; const float* sc = modl + bi * 9216 + iscale * 1024;
#pragma unroll
            for (int i = 0; i < 4; ++i) { v[q][i] = *(const float4*)(xr + i * 256 + lane * 4); sv[q][i] = *(const float4*)(sc + i * 256 + lane * 4); hv[q][i] = *(const float4*)(sh + i * 256 + lane * 4); }
        }
#pragma unroll
        for (int q = 0; q < 2; ++q) {
#pragma unroll
            for (int i = 0; i < 4; ++i) ss[q] += v[q][i].x * v[q][i].x + v[q][i].y * v[q][i].y + v[q][i].z * v[q][i].z + v[q][i].w * v[q][i].w;
        }
#pragma unroll
        for (int o = 1; o < 64; o <<= 1) { ss[0] += __shfl_xor(ss[0], o); ss[1] += __shfl_xor(ss[1], o); }
#pragma unroll
        for (int q = 0; q < 2; ++q) {
            const int row = row0 + q * (MT / 2);
            const float rstd = rsqrtf(ss[q] * (1.f / 1024.f) + EPS);
            float dta[8];
            if constexpr (WITH_DT) {
#pragma unroll
                for (int j = 0; j < 8; ++j) dta[j] = 0.f;
            }
#pragma unroll
            for (int i = 0; i < 4; ++i) {
                const int c = i * 256 + lane * 4;
                const float4 g = gv[i], s = sv[q][i], h = hv[q][i];
                const float o0 = v[q][i].x * rstd * g.x * (1.f + s.x) + h.x, o1 = v[q][i].y * rstd * g.y * (1.f + s.y) + h.y;
                const float o2 = v[q][i].z * rstd * g.z * (1.f + s.z) + h.z, o3 = v[q][i].w * rstd * g.w * (1.f + s.w) + h.w;
                uint2 o; o.x = pk2(o0, o1); o.y = pk2(o2, o3);
                *(uint2*)(H + (size_t)row * 1024 + c) = o;
                if constexpr (WITH_DT) {
#pragma unroll
                    for (int j = 0; j < 8; ++j) { const f32x4 w4 = *(const PG8_LAS f32x4*)(lf + j * 1024 + c); dta[j] += o0 * w4[0] + o1 * w4[1] + o2 * w4[2] + o3 * w4[3]; }
                }
            }
            if constexpr (WITH_DT) {
#pragma unroll
                for (int j = 0; j < 8; ++j) {
#pragma unroll
                    for (int o = 1; o < 64; o <<= 1) dta[j] += __shfl_xor(dta[j], o);
                }
                float mine = dta[0];
#pragma unroll
                for (int j = 1; j < 8; ++j) mine = lane == j ? dta[j] : mine;
                if (lane < 8) {
                    const float xx = mine + PIN(p, I_DTB)[l * 8 + lane];
                    const float e = __expf(-fabsf(xx)); const float lp = e < 0.02f ? e * (1.f - e * (0.5f - e * (1.f / 3.f))) : __logf(1.f + e);
                    ((float*)(ws + OFF_DT))[(size_t)row * 8 + lane] = fmaxf(xx, 0.f) + lp;
                }
            }
        }
    }
    if constexpr (WITH_DT) __syncthreads();
}
__device__ __forceinline__ void phase_final(const Params& p) {
    const float* X = (const float*)(WSP(p) + OFF_X); const float* gain = PIN(p, I_FNORM); float* outp = (float*)pin_load(30);
    const int lane = TIDX & 63, gw = BIDX * 8 + (TIDX >> 6), nw = gridDim.x * 8;
    for (int row = gw; row < ML; row += nw) {
        const float* xr = X + (size_t)row * 1024;
        float4 v[4]; float ss = 0.f;
#pragma unroll
        for (int i = 0; i < 4; ++i) { v[i] = *(const float4*)(xr + i * 256 + lane * 4); ss += v[i].x * v[i].x + v[i].y * v[i].y + v[i].z * v[i].z + v[i].w * v[i].w; }
#pragma unroll
        for (int o = 1; o < 64; o <<= 1) ss += __shfl_xor(ss, o);
        const float rstd = rsqrtf(ss * (1.f / 1024.f) + EPS);
#pragma unroll
        for (int i = 0; i < 4; ++i) {
            const int c = i * 256 + lane * 4; const float4 g = *(const float4*)(gain + c);
            float4 o; o.x = v[i].x * rstd * g.x; o.y = v[i].y * rstd * g.y; o.z = v[i].z * rstd * g.z; o.w = v[i].w * rstd * g.w;
            *(float4*)(outp + (size_t)row * 1024 + c) = o;
        }
    }
}

__device__ __forceinline__ void phase_rope_table() {
    float* T = (float*)(WSP(p) + OFF_ROPE);
    const size_t nthr = (size_t)gridDim.x * 512;
    for (size_t idx = (size_t)BIDX * 512 + TIDX; idx < (size_t)2048 * 32; idx += nthr) {
        const int pos = (int)(idx >> 5), k = (int)(idx & 31), axis = k >> 4, i = k & 15;
        const float inv = exp2f(-(float)i * (13.287712379549449f / 16.f));
        const float ang = (float)(axis == 0 ? (pos >> 6) : (pos & 63)) * inv;
        T[(size_t)pos * 64 + k] = cosf(ang); T[(size_t)pos * 64 + 32 + k] = sinf(ang);
    }
}
__device__ __forceinline__ void phase_prep(const Params& p, int l) {
    unsigned char* ws = WSP(p);
    bf16_t* __restrict__ P1 = (bf16_t*)(ws + OFF_BIG); const bf16_t* __restrict__ PT = (const bf16_t*)(ws + OFF_PT);
    bf16_t* __restrict__ BC = (bf16_t*)(ws + OFF_BC); bf16_t* __restrict__ XBT = (bf16_t*)(ws + OFF_XBT);
    const float* __restrict__ ROPE = (const float*)(ws + OFF_ROPE);
    const int tid = TIDX;
    const size_t gtid = (size_t)BIDX * 512 + tid, nthr = (size_t)gridDim.x * 512;
    {
        const float* __restrict__ gq = PIN(p, I_QNQ) + l * 64; const float* __restrict__ gk = PIN(p, I_QNK) + l * 64;
        for (size_t pr = gtid; pr < (size_t)MT * 12; pr += nthr) {
            const int row = (int)(pr / 12), slot = (int)(pr % 12);
            const bool lat = row < ML;
            if (!lat && slot < 6) continue;
            int col; const float* g = nullptr;
            if (slot < 4) col = slot * 64; else if (slot < 6) col = 256 + (slot - 4) * 64;
            else if (slot < 10) { col = 896 + (slot - 6) * 64; g = gq; } else { col = 1152 + (slot - 10) * 64; g = gk; }
            bf16_t* q = P1 + (size_t)row * P1W + col;
            float d[64];
#pragma unroll
            for (int c8 = 0; c8 < 8; ++c8) {
                const uint4 u = *(const uint4*)(q + c8 * 8);
                d[c8 * 8 + 0] = __uint_as_float(u.x << 16); d[c8 * 8 + 1] = __uint_as_float(u.x & 0xffff0000u); d[c8 * 8 + 2] = __uint_as_float(u.y << 16); d[c8 * 8 + 3] = __uint_as_float(u.y & 0xffff0000u);
                d[c8 * 8 + 4] = __uint_as_float(u.z << 16); d[c8 * 8 + 5] = __uint_as_float(u.z & 0xffff0000u); d[c8 * 8 + 6] = __uint_as_float(u.w << 16); d[c8 * 8 + 7] = __uint_as_float(u.w & 0xffff0000u);
            }
            if (g) {
                float ss = 0.f;
#pragma unroll
                for (int i = 0; i < 64; ++i) ss += d[i] * d[i];
                const float r = rsqrtf(ss * (1.f / 64.f) + EPS);
#pragma unroll
                for (int i = 0; i < 64; ++i) d[i] = d[i] * r * g[i];
            }
            if (lat) {
                const float* tr = ROPE + (size_t)(row & 2047) * 64;
#pragma unroll
                for (int ax = 0; ax < 2; ++ax)
#pragma unroll
                    for (int i4 = 0; i4 < 4; ++i4) {
                        const float4 c4 = *(const float4*)(tr + ax * 16 + i4 * 4), s4 = *(const float4*)(tr + 32 + ax * 16 + i4 * 4);
                        const float cc[4] = {c4.x, c4.y, c4.z, c4.w}, sn[4] = {s4.x, s4.y, s4.z, s4.w};
#pragma unroll
                        for (int j = 0; j < 4; ++j) {
                            const int i1 = ax * 32 + i4 * 4 + j, i2 = i1 + 16;
                            const float x1 = d[i1], x2 = d[i2];
                            d[i1] = x1 * cc[j] - x2 * sn[j]; d[i2] = x2 * cc[j] + x1 * sn[j];
                        }
                    }
            }
#pragma unroll
            for (int c8 = 0; c8 < 8; ++c8) {
                uint4 o; o.x = pk2(d[c8 * 8 + 0], d[c8 * 8 + 1]); o.y = pk2(d[c8 * 8 + 2], d[c8 * 8 + 3]); o.z = pk2(d[c8 * 8 + 4], d[c8 * 8 + 5]); o.w = pk2(d[c8 * 8 + 6], d[c8 * 8 + 7]);
                *(uint4*)(q + c8 * 8) = o;
            }
        }
    }
    const float* __restrict__ cw = PIN(p, I_CONVW) + (size_t)l * 5 * 768; const float* __restrict__ cb = PIN(p, I_CONVB) + (size_t)l * 768;
    for (size_t idx = gtid; idx < (size_t)MT * 64; idx += nthr) {
        const int row = (int)(idx >> 6), ch0 = (int)(idx & 63) * 8;
        int t, len; if (row < ML) { t = row & 2047; len = 2048; } else { t = (row - ML) & 255; len = 256; }
        uint4 u[5];
#pragma unroll
        for (int k = 0; k < 5; ++k) { const int tt = t + k - 2; u[k] = (tt >= 0 && tt < len) ? *(const uint4*)(P1 + (size_t)(row + k - 2) * P1W + 1536 + ch0) : make_uint4(0u, 0u, 0u, 0u); }
        float acc[8];
        { const float4 b0 = *(const float4*)(cb + 256 + ch0), b1 = *(const float4*)(cb + 256 + ch0 + 4); acc[0] = b0.x; acc[1] = b0.y; acc[2] = b0.z; acc[3] = b0.w; acc[4] = b1.x; acc[5] = b1.y; acc[6] = b1.z; acc[7] = b1.w; }
#pragma unroll
        for (int k = 0; k < 5; ++k) {
            const float4 w0 = *(const float4*)(cw + k * 768 + 256 + ch0), w1 = *(const float4*)(cw + k * 768 + 256 + ch0 + 4);
            acc[0] += __uint_as_float(u[k].x << 16) * w0.x; acc[1] += __uint_as_float(u[k].x & 0xffff0000u) * w0.y;
            acc[2] += __uint_as_float(u[k].y << 16) * w0.z; acc[3] += __uint_as_float(u[k].y & 0xffff0000u) * w0.w;
            acc[4] += __uint_as_float(u[k].z << 16) * w1.x; acc[5] += __uint_as_float(u[k].z & 0xffff0000u) * w1.y;
            acc[6] += __uint_as_float(u[k].w << 16) * w1.z; acc[7] += __uint_as_float(u[k].w & 0xffff0000u) * w1.w;
        }
        uint4 o; o.x = pk2(siluf(acc[0]), siluf(acc[1])); o.y = pk2(siluf(acc[2]), siluf(acc[3])); o.z = pk2(siluf(acc[4]), siluf(acc[5])); o.w = pk2(siluf(acc[6]), siluf(acc[7]));
        *(uint4*)(BC + (size_t)row * 512 + ch0) = o;
    }
    for (size_t idx = gtid; idx < (size_t)512 * (MT / 16); idx += nthr) {
        const int ch = (int)(idx / (MT / 16)), m0 = (int)(idx % (MT / 16)) * 16;
        int t0, len; if (m0 < ML) { t0 = m0 & 2047; len = 2048; } else { t0 = (m0 - ML) & 255; len = 256; }
        const bf16_t* src = PT + (size_t)(512 + ch) * MT + m0;
        float in[20];
        const uint4 ua = *(const uint4*)src, ub = *(const uint4*)(src + 8);
        in[2] = __uint_as_float(ua.x << 16); in[3] = __uint_as_float(ua.x & 0xffff0000u); in[4] = __uint_as_float(ua.y << 16); in[5] = __uint_as_float(ua.y & 0xffff0000u);
        in[6] = __uint_as_float(ua.z << 16); in[7] = __uint_as_float(ua.z & 0xffff0000u); in[8] = __uint_as_float(ua.w << 16); in[9] = __uint_as_float(ua.w & 0xffff0000u);
        in[10] = __uint_as_float(ub.x << 16); in[11] = __uint_as_float(ub.x & 0xffff0000u); in[12] = __uint_as_float(ub.y << 16); in[13] = __uint_as_float(ub.y & 0xffff0000u);
        in[14] = __uint_as_float(ub.z << 16); in[15] = __uint_as_float(ub.z & 0xffff0000u); in[16] = __uint_as_float(ub.w << 16); in[17] = __uint_as_float(ub.w & 0xffff0000u);
        in[0] = t0 >= 2 ? bf2f(src[-2]) : 0.f; in[1] = t0 >= 1 ? bf2f(src[-1]) : 0.f;
        in[18] = t0 + 16 < len ? bf2f(src[16]) : 0.f; in[19] = t0 + 17 < len ? bf2f(src[17]) : 0.f;
        const float w0 = cw[ch], w1 = cw[768 + ch], w2 = cw[2 * 768 + ch], w3 = cw[3 * 768 + ch], w4 = cw[4 * 768 + ch], bb = cb[ch];
        float o[16];
#pragma unroll
        for (int i = 0; i < 16; ++i) o[i] = siluf(bb + in[i] * w0 + in[i + 1] * w1 + in[i + 2] * w2 + in[i + 3] * w3 + in[i + 4] * w4);
        uint4 oa, ob; oa.x = pk2(o[0], o[1]); oa.y = pk2(o[2], o[3]); oa.z = pk2(o[4], o[5]); oa.w = pk2(o[6], o[7]);
        ob.x = pk2(o[8], o[9]); ob.y = pk2(o[10], o[11]); ob.z = pk2(o[12], o[13]); ob.w = pk2(o[14], o[15]);
        *(uint4*)(XBT + (size_t)ch * MT + m0) = oa; *(uint4*)(XBT + (size_t)ch * MT + m0 + 8) = ob;
    }
}
struct AttnAcc { f32x4 o[4]; float m, l; };
__device__ __forceinline__ void attn_init(AttnAcc& a) {
#pragma unroll
    for (int i = 0; i < 4; ++i) a.o[i] = (f32x4){0.f, 0.f, 0.f, 0.f};
    a.m = -1e30f; a.l = 0.f;
}
__device__ __forceinline__ void attn_finish(AttnAcc& a, float sink_l2, bool has_sink, bf16_t* yrow, int lane) {
    float l = a.l; l += __shfl_xor(l, 16); l += __shfl_xor(l, 32);
    if (has_sink) l += ex2(sink_l2 - a.m);
    const float inv = 1.f / l; const int quad = lane >> 4;
#pragma unroll
    for (int dt = 0; dt < 4; ++dt) { uint2 o; o.x = pk2(a.o[dt][0] * inv, a.o[dt][1] * inv); o.y = pk2(a.o[dt][2] * inv, a.o[dt][3] * inv); *(uint2*)(yrow + dt * 16 + quad * 4) = o; }
}
__device__ __forceinline__ void load_q(bf16x8 (&qf)[2], const bf16_t* qrow, int lane) { const int quad = lane >> 4; qf[0] = *(const bf16x8*)(qrow + quad * 8); qf[1] = *(const bf16x8*)(qrow + 32 + quad * 8); }

constexpr float SC_ATT = 0.125f * LOG2E;
#define NEG_INF_F (-__builtin_inff())
constexpr int AT_LD = 72;
constexpr int AT_STAGE = 2 * 64 * AT_LD;

__device__ __forceinline__ int vpos4(int k) { return ((k >> 5) << 5) + (((k >> 2) & 3) << 3) + (((k >> 4) & 1) << 2); }
__device__ __forceinline__ void attn_step2_lds(AttnAcc& a, const bf16x8 (&qf)[2], const PG8_LAS bf16_t* Kl, const PG8_LAS bf16_t* Vl, int c0, f32x4 add0, f32x4 add1, int lane) {
    const int kr = lane & 15, quad = lane >> 4;
    const PG8_LAS bf16_t* kp = Kl + (c0 + kr) * AT_LD + quad * 8;
    const bf16x8 k00 = *(const PG8_LAS bf16x8*)kp, k01 = *(const PG8_LAS bf16x8*)(kp + 32);
    const bf16x8 k10 = *(const PG8_LAS bf16x8*)(kp + 16 * AT_LD), k11 = *(const PG8_LAS bf16x8*)(kp + 16 * AT_LD + 32);
    bf16x8 va[4];
#pragma unroll
    for (int dt = 0; dt < 4; ++dt) {
        const PG8_LAS bf16_t* vr = Vl + (dt * 16 + kr) * AT_LD;
        const bf16x4 lo = *(const PG8_LAS bf16x4*)(vr + vpos4(c0 + quad * 4)), hi = *(const PG8_LAS bf16x4*)(vr + vpos4(c0 + 16 + quad * 4));
        va[dt] = __builtin_shufflevector(lo, hi, 0, 1, 2, 3, 4, 5, 6, 7);
    }
    f32x4 s0 = (f32x4){0.f, 0.f, 0.f, 0.f}, s1 = (f32x4){0.f, 0.f, 0.f, 0.f};
    s0 = MFMA32(k00, qf[0], s0); s1 = MFMA32(k10, qf[0], s1); s0 = MFMA32(k01, qf[1], s0); s1 = MFMA32(k11, qf[1], s1);
    float v[8];
#pragma unroll
    for (int j = 0; j < 4; ++j) { v[j] = s0[j] * SC_ATT + add0[j]; v[4 + j] = s1[j] * SC_ATT + add1[j]; }
    float tm = fmaxf(fmaxf(fmaxf(v[0], v[1]), fmaxf(v[2], v[3])), fmaxf(fmaxf(v[4], v[5]), fmaxf(v[6], v[7])));
    tm = fmaxf(tm, __shfl_xor(tm, 16)); tm = fmaxf(tm, __shfl_xor(tm, 32));
    const float mn = fmaxf(a.m, tm);
    if (__any(mn > a.m)) {
        const float alpha = ex2(a.m - mn);
        a.l *= alpha;
#pragma unroll
        for (int dt = 0; dt < 4; ++dt) a.o[dt] *= alpha;
        a.m = mn;
    }
    float ps = 0.f; u32x4 pw;
#pragma unroll
    for (int j = 0; j < 4; ++j) { const float pa = ex2(v[2 * j] - mn), pc = ex2(v[2 * j + 1] - mn); ps += pa + pc; pw[j] = pk2(pa, pc); }
    a.l += ps;
    const bf16x8 pb = __builtin_bit_cast(bf16x8, pw);
#pragma unroll
    for (int dt = 0; dt < 4; ++dt) a.o[dt] = MFMA32(va[dt], pb, a.o[dt]);
}
__device__ __forceinline__ void attn_step4_lds(AttnAcc& a, const bf16x8 (&qf)[2], const PG8_LAS bf16_t* Kl, const PG8_LAS bf16_t* Vl, int lane) {
    const int kr = lane & 15, quad = lane >> 4;
    const PG8_LAS bf16_t* kp = Kl + kr * AT_LD + quad * 8;
    f32x4 sv[4];
#pragma unroll
    for (int t = 0; t < 4; ++t) {
        const bf16x8 k0 = *(const PG8_LAS bf16x8*)(kp + t * 16 * AT_LD), k1 = *(const PG8_LAS bf16x8*)(kp + t * 16 * AT_LD + 32);
        f32x4 z = (f32x4){0.f, 0.f, 0.f, 0.f};
        z = MFMA32(k0, qf[0], z); sv[t] = MFMA32(k1, qf[1], z);
    }
    float tm = sv[0][0];
#pragma unroll
    for (int t = 0; t < 4; ++t)
#pragma unroll
        for (int j = 0; j < 4; ++j) tm = fmaxf(tm, sv[t][j]);
    tm *= SC_ATT;
    tm = fmaxf(tm, __shfl_xor(tm, 16)); tm = fmaxf(tm, __shfl_xor(tm, 32));
    const float mn = fmaxf(a.m, tm);
    if (__any(mn > a.m)) {
        const float alpha = ex2(a.m - mn);
        a.l *= alpha;
#pragma unroll
        for (int dt = 0; dt < 4; ++dt) a.o[dt] *= alpha;
        a.m = mn;
    }
    float ps = 0.f; u32x4 pw[2];
#pragma unroll
    for (int h2 = 0; h2 < 2; ++h2)
#pragma unroll
        for (int j = 0; j < 4; ++j) {
            const int t = h2 * 2 + (j >> 1), e = (j & 1) * 2;
            const float pa = ex2(__builtin_fmaf(sv[t][e], SC_ATT, -mn)), pc = ex2(__builtin_fmaf(sv[t][e + 1], SC_ATT, -mn));
            ps += pa + pc; pw[h2][j] = pk2(pa, pc);
        }
    a.l += ps;
#pragma unroll
    for (int h2 = 0; h2 < 2; ++h2) {
        const bf16x8 pb = __builtin_bit_cast(bf16x8, pw[h2]);
#pragma unroll
        for (int dt = 0; dt < 4; ++dt) {
            const bf16x8 vv = *(const PG8_LAS bf16x8*)(Vl + (dt * 16 + kr) * AT_LD + h2 * 32 + quad * 8);
            a.o[dt] = MFMA32(vv, pb, a.o[dt]);
        }
    }
}
template <class TileFn, class WaveFn>
__device__ __forceinline__ void attn_block_loop(int ntiles, int kcol, int vrow, const bf16_t* __restrict__ P1, const bf16_t* __restrict__ PT, PG8_LAS bf16_t* lds, int tid, TileFn tile_row, WaveFn wf) {
    const int r = tid >> 3, c = tid & 7;
    u32x4 kreg, vreg;
    { const size_t row0 = tile_row(0); kreg = *(const u32x4*)(P1 + (row0 + r) * P1W + kcol + c * 8); vreg = *(const u32x4*)(PT + (size_t)(vrow + r) * MT + row0 + c * 8); }
    const int vp0 = ((c >> 2) << 5) + ((c & 1) << 4) + (((c >> 1) & 1) << 2);
    *(PG8_LAS u32x4*)(lds + r * AT_LD + c * 8) = kreg;
    { u32x2 lo2, hi2; lo2[0] = vreg[0]; lo2[1] = vreg[1]; hi2[0] = vreg[2]; hi2[1] = vreg[3]; *(PG8_LAS u32x2*)(lds + 64 * AT_LD + r * AT_LD + vp0) = lo2; *(PG8_LAS u32x2*)(lds + 64 * AT_LD + r * AT_LD + vp0 + 8) = hi2; }
    __syncthreads();
#pragma unroll 1
    for (int ti = 0; ti < ntiles; ++ti) {
        PG8_LAS bf16_t* cur = lds + (ti & 1) * AT_STAGE; PG8_LAS bf16_t* nxt = lds + ((ti + 1) & 1) * AT_STAGE;
        const bool more = ti + 1 < ntiles;
        if (more) { const size_t row0 = tile_row(ti + 1); kreg = *(const u32x4*)(P1 + (row0 + r) * P1W + kcol + c * 8); vreg = *(const u32x4*)(PT + (size_t)(vrow + r) * MT + row0 + c * 8); }
        wf(ti, cur, cur + 64 * AT_LD);
        if (more) { *(PG8_LAS u32x4*)(nxt + r * AT_LD + c * 8) = kreg;
                    u32x2 lo2, hi2; lo2[0] = vreg[0]; lo2[1] = vreg[1]; hi2[0] = vreg[2]; hi2[1] = vreg[3]; *(PG8_LAS u32x2*)(nxt + 64 * AT_LD + r * AT_LD + vp0) = lo2; *(PG8_LAS u32x2*)(nxt + 64 * AT_LD + r * AT_LD + vp0 + 8) = hi2; }
        __syncthreads();
    }
}
__device__ __forceinline__ void ga_block(const Params& p, int u, PG8_LAS bf16_t* lds) {
    const bf16_t* P1 = (const bf16_t*)(WSP(p) + OFF_BIG); const bf16_t* PT = (const bf16_t*)(WSP(p) + OFF_PT); bf16_t* Y = (bf16_t*)(WSP(p) + OFF_Y);
    const int tid = TIDX, lane = tid & 63, wave = tid >> 6;
    const int qb = u & 15, qh = (u >> 4) & 3, b = u >> 6, kvh = qh >> 1;
    const size_t qrow = (size_t)b * 2048 + qb * 128 + wave * 16 + (lane & 15);
    bf16x8 qf[2]; load_q(qf, P1 + qrow * P1W + 896 + qh * 64, lane);
    AttnAcc a; attn_init(a);
    const f32x4 z = (f32x4){0.f, 0.f, 0.f, 0.f};
    attn_block_loop(36, 1152 + kvh * 64, 384 + kvh * 64, P1, PT, lds, tid,
        [&](int ti) -> size_t { return ti < 4 ? (size_t)ML + b * 256 + ti * 64 : (size_t)b * 2048 + (ti - 4) * 64; },
        [&](int ti, const PG8_LAS bf16_t* Kl, const PG8_LAS bf16_t* Vl) {
            attn_step4_lds(a, qf, Kl, Vl, lane);
        });
    attn_finish(a, 0.f, false, Y + qrow * 1024 + 512 + qh * 64, lane);
}
__device__ __forceinline__ void wa_block(const Params& p, int l, int u, PG8_LAS bf16_t* lds) {
    const bf16_t* P1 = (const bf16_t*)(WSP(p) + OFF_BIG); const bf16_t* PT = (const bf16_t*)(WSP(p) + OFF_PT); bf16_t* Y = (bf16_t*)(WSP(p) + OFF_Y);
    const int tid = TIDX, lane = tid & 63, wave = tid >> 6, quad = lane >> 4;
    const int qb = u & 15, qh = (u >> 4) & 3, b = u >> 6, kvh = qh >> 1;
    const int i0 = qb * 128 + wave * 16, i = i0 + (lane & 15);
    const size_t qrow = (size_t)b * 2048 + i;
    bf16x8 qf[2]; load_q(qf, P1 + qrow * P1W + qh * 64, lane);
    AttnAcc a; attn_init(a);
    const int jlo = max(qb * 128 - 128, 0), jhi = min(qb * 128 + 256, 2048);
    const f32x4 z = (f32x4){0.f, 0.f, 0.f, 0.f};
    attn_block_loop(4 + (jhi - jlo) / 64, 256 + kvh * 64, kvh * 64, P1, PT, lds, tid,
        [&](int ti) -> size_t { return ti < 4 ? (size_t)ML + b * 256 + ti * 64 : (size_t)b * 2048 + jlo + (ti - 4) * 64; },
        [&](int ti, const PG8_LAS bf16_t* Kl, const PG8_LAS bf16_t* Vl) {
            if (ti < 4) {
                attn_step4_lds(a, qf, Kl, Vl, lane);
            } else {
                const int j0t = jlo + (ti - 4) * 64;
#pragma unroll
                for (int pr = 0; pr < 2; ++pr) {
                    const int j0 = j0t + pr * 32;
                    if (j0 + 16 >= i0 - 128 && j0 <= i0 + 128) {
                        f32x4 add0, add1;
#pragma unroll
                        for (int jj = 0; jj < 4; ++jj) {
                            const int d0 = i - (j0 + quad * 4 + jj), d1 = d0 - 16;
                            add0[jj] = (d0 <= 128 && d0 >= -128) ? 0.f : NEG_INF_F; add1[jj] = (d1 <= 128 && d1 >= -128) ? 0.f : NEG_INF_F;
                        }
                        attn_step2_lds(a, qf, Kl, Vl, pr * 32, add0, add1, lane);
                    }
                }
            }
        });
    attn_finish(a, PIN(p, I_SINK)[l * 4 + qh] * LOG2E, true, Y + qrow * 1024 + qh * 64, lane);
}
__device__ __forceinline__ void na_block(const Params& p, int l, int u, PG8_LAS bf16_t* lds) {
    const bf16_t* P1 = (const bf16_t*)(WSP(p) + OFF_BIG); const bf16_t* PT = (const bf16_t*)(WSP(p) + OFF_PT); bf16_t* Y = (bf16_t*)(WSP(p) + OFF_Y);
    const int tid = TIDX, lane = tid & 63, wave = tid >> 6, quad = lane >> 4;
    const int rp = u & 15, h = (u >> 4) & 3, b = u >> 6;
    const int r0 = rp * 2, r = r0 + (wave >> 2), jb = wave & 3;
    const size_t qrow = (size_t)b * 2048 + r * 64 + jb * 16 + (lane & 15);
    bf16x8 qf[2]; load_q(qf, P1 + qrow * P1W + 384 + h * 64, lane);
    AttnAcc a; attn_init(a);
    const int rs0 = min(max(r0 - 4, 0), 24), rs1 = min(max(r0 + 1 - 4, 0), 24), nrows = rs1 + 8 - rs0;
    const int rs = min(max(r - 4, 0), 24), kcol_start = min(max(jb * 16 - 8, 0), 32);
    const int qc = jb * 16 + (lane & 15), qcs = min(max(qc - 8, 0), 48);
    const float* rpb = PIN(p, I_RPB) + (size_t)(l * 4 + h) * 15 * 31;
    const f32x4 z = (f32x4){0.f, 0.f, 0.f, 0.f};
    attn_block_loop(4 + nrows, 640 + h * 64, 128 + h * 64, P1, PT, lds, tid,
        [&](int ti) -> size_t { return ti < 4 ? (size_t)ML + b * 256 + ti * 64 : (size_t)b * 2048 + (rs0 + ti - 4) * 64; },
        [&](int ti, const PG8_LAS bf16_t* Kl, const PG8_LAS bf16_t* Vl) {
            if (ti < 4) {
                attn_step4_lds(a, qf, Kl, Vl, lane);
            } else {
                const int keyrow = rs0 + ti - 4;
                if (keyrow >= rs && keyrow < rs + 8) {
                    const int dr = keyrow - r + 7;
                    f32x4 add0, add1;
#pragma unroll
                    for (int jj = 0; jj < 4; ++jj) {
                        const int kc0 = kcol_start + quad * 4 + jj, kc1 = kc0 + 16;
                        const bool ok0 = kc0 >= qcs && kc0 < qcs + 16, ok1 = kc1 >= qcs && kc1 < qcs + 16;
                        const int dc0 = min(max(kc0 - qc + 15, 0), 30), dc1 = min(max(kc1 - qc + 15, 0), 30);
                        add0[jj] = ok0 ? rpb[dr * 31 + dc0] * LOG2E : NEG_INF_F; add1[jj] = ok1 ? rpb[dr * 31 + dc1] * LOG2E : NEG_INF_F;
                    }
                    attn_step2_lds(a, qf, Kl, Vl, kcol_start, add0, add1, lane);
                }
            }
        });
    attn_finish(a, 0.f, false, Y + qrow * 1024 + 256 + h * 64, lane);
}
__device__ __forceinline__ void ctx_block(const Params& p, int l, int u, PG8_LAS bf16_t* lds) {
    const bf16_t* P1 = (const bf16_t*)(WSP(p) + OFF_BIG); const bf16_t* PT = (const bf16_t*)(WSP(p) + OFF_PT); bf16_t* Y = (bf16_t*)(WSP(p) + OFF_Y);
    const int tid = TIDX, lane = tid & 63, wave = tid >> 6;
    const int half = u & 1, h = (u >> 1) & 3, b = (u >> 3) & 7, mx = u >> 6;
    const size_t qrow = (size_t)ML + b * 256 + half * 128 + wave * 16 + (lane & 15);
    int qcol, kcol, vrow;
    if (mx == 0) { qcol = h * 64; kcol = 256 + (h >> 1) * 64; vrow = (h >> 1) * 64; }
    else if (mx == 1) { qcol = 384 + h * 64; kcol = 640 + h * 64; vrow = 128 + h * 64; }
    else { qcol = 896 + h * 64; kcol = 1152 + (h >> 1) * 64; vrow = 384 + (h >> 1) * 64; }
    bf16x8 qf[2]; load_q(qf, P1 + qrow * P1W + qcol, lane);
    AttnAcc a; attn_init(a);
    const f32x4 z = (f32x4){0.f, 0.f, 0.f, 0.f};
    attn_block_loop(4, kcol, vrow, P1, PT, lds, tid,
        [&](int ti) -> size_t { return (size_t)ML + b * 256 + ti * 64; },
        [&](int ti, const PG8_LAS bf16_t* Kl, const PG8_LAS bf16_t* Vl) {
            attn_step4_lds(a, qf, Kl, Vl, lane);
        });
    attn_finish(a, PIN(p, I_SINK)[l * 4 + h] * LOG2E, mx == 0, Y + qrow * 1024 + mx * 256 + h * 64, lane);
}

__device__ __forceinline__ size_t chunk_row0(int b, int k) { return k < 2 ? (size_t)ML + b * 256 + k * 128 : (size_t)b * 2048 + (k - 2) * 128; }
__device__ __forceinline__ void ssm_a_item(const Params& p, int l, int item, PG8_LAS float* lf) {
    unsigned char* ws = WSP(p);
    const bf16_t* XBT = (const bf16_t*)(ws + OFF_XBT); const float* DT = (const float*)(ws + OFF_DT);
    float* CUM = (float*)(ws + OFF_CUM); float* TOT = (float*)(ws + OFF_TOT); float* ST = (float*)(ws + OFF_ST);
    const int b = item / 18, k = item % 18, tid = TIDX, lane = tid & 63, wave = tid >> 6, h = wave & 3, dir = wave >> 2, j8 = dir * 4 + h, quad = lane >> 4, fr = lane & 15;
    const size_t m0 = chunk_row0(b, k);
    const float av = -__expf(PIN(p, I_ALOG)[l * 8 + j8]);
    const float d0 = DT[(m0 + lane) * 8 + j8], d1 = DT[(m0 + 64 + lane) * 8 + j8];
    const float v0 = d0 * av, v1 = d1 * av;
    float p0 = v0, p1 = v1;
#pragma unroll
    for (int o = 1; o < 64; o <<= 1) { const float t0 = __shfl_up(p0, o), t1 = __shfl_up(p1, o); if (lane >= o) { p0 += t0; p1 += t1; } }
    const float tot0 = __shfl(p0, 63), tot1 = __shfl(p1, 63), tot = tot0 + tot1;
    float c0, c1;
    if (dir == 0) { c0 = p0; c1 = tot0 + p1; } else { c0 = tot - (p0 - v0); c1 = tot - (tot0 + p1 - v1); }
    CUM[(m0 + lane) * 8 + j8] = c0; CUM[(m0 + 64 + lane) * 8 + j8] = c1;
    if (lane == 0) TOT[(size_t)(b * 18 + k) * 8 + j8] = tot;
    PG8_LAS float* sw = lf + wave * 128;
    sw[lane] = d0 * __expf(tot - c0); sw[lane + 64] = d1 * __expf(tot - c1);
    __syncthreads();
    const int g = h >> 1;
    const bf16_t* xT = XBT + (size_t)(h * 64) * MT + m0; const bf16_t* bT = XBT + (size_t)(256 + g * 128) * MT + m0;
    float* dst = ST + ((size_t)(b * 18 + k) * 8 + j8) * 8192;
#pragma unroll 1
    for (int nh = 0; nh < 2; ++nh) {
        f32x4 acc[4][4];
#pragma unroll
        for (int i = 0; i < 4; ++i)
#pragma unroll
            for (int j = 0; j < 4; ++j) acc[i][j] = (f32x4){0.f, 0.f, 0.f, 0.f};
#pragma unroll 1
        for (int ks = 0; ks < 4; ++ks) {
            const int l0 = ks * 32 + quad * 8;
            bf16x8 af[4];
#pragma unroll
            for (int pt = 0; pt < 4; ++pt) {
                const bf16x8 xv = *(const bf16x8*)(xT + (size_t)(pt * 16 + fr) * MT + l0);
#pragma unroll
                for (int j = 0; j < 8; ++j) af[pt][j] = (short)f2bf(bf2f((bf16_t)xv[j]) * sw[l0 + j]);
            }
#pragma unroll
            for (int nt = 0; nt < 4; ++nt) {
                const bf16x8 bv = *(const bf16x8*)(bT + (size_t)((nh * 4 + nt) * 16 + fr) * MT + l0);
#pragma unroll
                for (int pt = 0; pt < 4; ++pt) acc[pt][nt] = MFMA32(af[pt], bv, acc[pt][nt]);
            }
        }
#pragma unroll
        for (int pt = 0; pt < 4; ++pt)
#pragma unroll
            for (int nt = 0; nt < 4; ++nt)
#pragma unroll
                for (int j = 0; j < 4; ++j) dst[(pt * 16 + quad * 4 + j) * 128 + (nh * 4 + nt) * 16 + fr] = acc[pt][nt][j];
    }
    __syncthreads();
}
__device__ __forceinline__ void phase_ssm_scan(const Params& p) {
    unsigned char* ws = WSP(p);
    const float* ST = (const float*)(ws + OFF_ST); const float* TOT = (const float*)(ws + OFF_TOT); bf16_t* SIN = (bf16_t*)(ws + OFF_SIN);
    const size_t nthr = (size_t)gridDim.x * 512;
    for (size_t idx = (size_t)BIDX * 512 + TIDX; idx < (size_t)NBATCH * 8 * 2048; idx += nthr) {
        const int e4 = (int)(idx & 2047), j8 = (int)(idx >> 11) & 7, b = (int)(idx >> 14), dir = j8 >> 2;
        float4 sv = make_float4(0.f, 0.f, 0.f, 0.f);
#pragma unroll 1
        for (int s0 = 0; s0 < 18; s0 += 6) {
            float4 tv[6]; float dec[6];
#pragma unroll
            for (int q = 0; q < 6; ++q) {
                const int st = s0 + q, kk = dir == 0 ? st : (st < 2 ? 1 - st : 19 - st);
                tv[q] = *(const float4*)(ST + ((size_t)(b * 18 + kk) * 8 + j8) * 8192 + e4 * 4);
                dec[q] = TOT[(size_t)(b * 18 + kk) * 8 + j8];
            }
#pragma unroll
            for (int q = 0; q < 6; ++q) {
                const int st = s0 + q, kk = dir == 0 ? st : (st < 2 ? 1 - st : 19 - st);
                const size_t base = ((size_t)(b * 18 + kk) * 8 + j8) * 8192 + e4 * 4;
                uint2 o; o.x = pk2(sv.x, sv.y); o.y = pk2(sv.z, sv.w);
                *(uint2*)(SIN + base) = o;
                const float d = __expf(dec[q]); const float4 t = tv[q];
                sv.x = sv.x * d + t.x; sv.y = sv.y * d + t.y; sv.z = sv.z * d + t.z; sv.w = sv.w * d + t.w;
            }
        }
    }
}
#ifndef SSMB_UNROLL_H
#define SSMB_UNROLL_H 4
#endif
constexpr int SS_LD = 136;
__device__ __forceinline__ void ssm_b_item(const Params& p, int l, int item, PG8_LAS unsigned char* lds) {
    unsigned char* ws = WSP(p);
    const bf16_t* XBT = (const bf16_t*)(ws + OFF_XBT); const bf16_t* BC = (const bf16_t*)(ws + OFF_BC); const bf16_t* P1 = (const bf16_t*)(ws + OFF_BIG);
    const float* DT = (const float*)(ws + OFF_DT); const float* CUM = (const float*)(ws + OFF_CUM); const float* TOT = (const float*)(ws + OFF_TOT); const float* ST = (const float*)(ws + OFF_ST);
    bf16_t* Y = (bf16_t*)(ws + OFF_Y);
    const int b = item / 18, k = item % 18, tid = TIDX, lane = tid & 63, wave = tid >> 6, quad = lane >> 4, fr = lane & 15;
    const size_t m0 = chunk_row0(b, k);
    const bf16_t* SIN = (const bf16_t*)(ws + OFF_SIN) + (size_t)(b * 18 + k) * 8 * 8192;
    PG8_LAS float* ysb = (PG8_LAS float*)lds;
    PG8_LAS float* scum = (PG8_LAS float*)(lds + 131072);
    PG8_LAS float* sdt = scum + 1024;
    for (int i = tid; i < 1024; i += 512) { scum[i] = CUM[m0 * 8 + i]; sdt[i] = DT[m0 * 8 + i]; }
    __syncthreads();
    const int t = wave * 16 + fr; const size_t mt = m0 + t;
    float ss = 0.f;
#pragma unroll 1
    for (int h = 0; h < 4; ++h) {
        const int g = h >> 1;
        bf16x8 cf[4];
#pragma unroll
        for (int ks = 0; ks < 4; ++ks) cf[ks] = *(const bf16x8*)(BC + mt * 512 + 256 + g * 128 + ks * 32 + quad * 8);
        const float cumF_t = scum[t * 8 + h], revB_t = scum[t * 8 + 4 + h];
        f32x4 yacc[4];
#pragma unroll
        for (int pt = 0; pt < 4; ++pt) yacc[pt] = (f32x4){0.f, 0.f, 0.f, 0.f};
#pragma unroll 1
        for (int sp = 0; sp < 4; ++sp) {
            bf16x8 bfr[2][4]; bf16x4 xa[2][4];
#pragma unroll
            for (int q = 0; q < 2; ++q) {
                const int st = sp * 2 + q;
                const bf16_t* brow = BC + (m0 + st * 16 + fr) * 512 + g * 128 + quad * 8;
#pragma unroll
                for (int ks = 0; ks < 4; ++ks) bfr[q][ks] = *(const bf16x8*)(brow + ks * 32);
#pragma unroll
                for (int pt = 0; pt < 4; ++pt) xa[q][pt] = *(const bf16x4*)(XBT + (size_t)(h * 64 + pt * 16 + fr) * MT + m0 + st * 16 + quad * 4);
            }
#pragma unroll
            for (int q = 0; q < 2; ++q) {
                const int st = sp * 2 + q;
                f32x4 G = (f32x4){0.f, 0.f, 0.f, 0.f};
#pragma unroll
                for (int ks = 0; ks < 4; ++ks) G = MFMA32(bfr[q][ks], cf[ks], G);
                bf16x4 pb;
#pragma unroll
                for (int j = 0; j < 4; ++j) {
                    const int s_ = st * 16 + quad * 4 + j;
                    const float eF = s_ <= t ? cumF_t - scum[s_ * 8 + h] : NEG_INF_F, eB = s_ >= t ? revB_t - scum[s_ * 8 + 4 + h] : NEG_INF_F;
                    const float w = __expf(eF) * sdt[s_ * 8 + h] + __expf(eB) * sdt[s_ * 8 + 4 + h];
                    pb[j] = (short)f2bf(G[j] * w);
                }
#pragma unroll
                for (int pt = 0; pt < 4; ++pt) yacc[pt] = MFMA16(xa[q][pt], pb, yacc[pt]);
            }
        }
#pragma unroll
        for (int dir = 0; dir < 2; ++dir) {
            bf16x8 sf[16];
#pragma unroll
            for (int ks = 0; ks < 4; ++ks)
#pragma unroll
                for (int pt = 0; pt < 4; ++pt) sf[ks * 4 + pt] = *(const bf16x8*)(SIN + (size_t)((dir * 4 + h) * 64 + pt * 16 + fr) * 128 + ks * 32 + quad * 8);
            f32x4 a2[4];
#pragma unroll
            for (int pt = 0; pt < 4; ++pt) a2[pt] = (f32x4){0.f, 0.f, 0.f, 0.f};
#pragma unroll
            for (int ks = 0; ks < 4; ++ks)
#pragma unroll
                for (int pt = 0; pt < 4; ++pt) a2[pt] = MFMA32(sf[ks * 4 + pt], cf[ks], a2[pt]);
            const float e = __expf(dir == 0 ? cumF_t : revB_t);
#pragma unroll
            for (int pt = 0; pt < 4; ++pt) yacc[pt] += e * a2[pt];
        }
        const float Dh = PIN(p, I_SSMD)[l * 4 + h];
        PG8_LAS float* ys = ysb + (h * 8 + wave) * 1024;
#pragma unroll
        for (int pt = 0; pt < 4; ++pt) {
            const uint2 zz = *(const uint2*)(P1 + mt * P1W + 1280 + h * 64 + pt * 16 + quad * 4);
            const float z0 = __uint_as_float(zz.x << 16), z1 = __uint_as_float(zz.x & 0xffff0000u), z2 = __uint_as_float(zz.y << 16), z3 = __uint_as_float(zz.y & 0xffff0000u);
            const bf16_t* xp = XBT + (size_t)(h * 64 + pt * 16 + quad * 4) * MT + mt;
            f32x4 y;
            y[0] = (yacc[pt][0] + Dh * bf2f(xp[0])) * siluf(z0); y[1] = (yacc[pt][1] + Dh * bf2f(xp[MT])) * siluf(z1);
            y[2] = (yacc[pt][2] + Dh * bf2f(xp[2 * (size_t)MT])) * siluf(z2); y[3] = (yacc[pt][3] + Dh * bf2f(xp[3 * (size_t)MT])) * siluf(z3);
            ss += y[0] * y[0] + y[1] * y[1] + y[2] * y[2] + y[3] * y[3];
            *(PG8_LAS f32x4*)(ys + (pt * 64 + lane) * 4) = y;
        }
    }
    ss += __shfl_xor(ss, 16); ss += __shfl_xor(ss, 32);
    const float rstd = rsqrtf(ss * (1.f / 256.f) + EPS);
    const float* gn = PIN(p, I_SSMN) + l * 256;
#pragma unroll 1
    for (int h = 0; h < 4; ++h) {
        PG8_LAS float* ys = ysb + (h * 8 + wave) * 1024;
#pragma unroll
        for (int pt = 0; pt < 4; ++pt) {
            const f32x4 y = *(PG8_LAS f32x4*)(ys + (pt * 64 + lane) * 4);
            const int c = h * 64 + pt * 16 + quad * 4; const float4 g4 = *(const float4*)(gn + c);
            uint2 o; o.x = pk2(y[0] * rstd * g4.x, y[1] * rstd * g4.y); o.y = pk2(y[2] * rstd * g4.z, y[3] * rstd * g4.w);
            *(uint2*)(Y + mt * 1024 + 768 + c) = o;
        }
    }
    __syncthreads();
}

#define XB_TID ((int)threadIdx.x)
#define XB_TMO      128
#define XB_XCNT(j)  (256  + 64 * (j))
#define XB_XSUB(j)  (1280 + 64 * (j))
#define XB_XGEN(j)  (2304 + 64 * (j))
#define XB_TOP      3328
#define XB_TOPGEN   3392
#define XCD_BAR_WORDS 3456
#define XB_SPIN_CAP (1u << 18)
#define LAS PG8_LAS

__device__ __forceinline__ unsigned xb_ld(unsigned* p)              { return __hip_atomic_load(p, __ATOMIC_RELAXED, __HIP_MEMORY_SCOPE_AGENT); }
__device__ __forceinline__ unsigned xb_add(unsigned* p, unsigned v) { return __hip_atomic_fetch_add(p, v, __ATOMIC_RELAXED, __HIP_MEMORY_SCOPE_AGENT); }
__device__ __forceinline__ unsigned xb_xcc_id() { return (unsigned)__builtin_amdgcn_s_getreg((3 << 11) | 20) & 0xFu; }
#define XB_SPIN(cond, bar) do { unsigned _sp = 0; while (cond) { __builtin_amdgcn_s_sleep(1); \
    if ((++_sp & 255u) == 0u) { if (xb_ld(&(bar)[XB_TMO])) break; if (_sp > XB_SPIN_CAP) { atomicAdd(&(bar)[XB_TMO], 1u); break; } } } } while (0)

struct XcdBarrier {
    unsigned* bar; unsigned x;
    volatile LAS unsigned* st;
};

__device__ __forceinline__ XcdBarrier xcd_barrier_post(unsigned* bar, volatile LAS unsigned* st) {
    XcdBarrier b; b.bar = bar; b.x = xb_xcc_id(); b.st = st;
    if (XB_TID == 0) (void)xb_add(&bar[XB_XCNT(b.x)], 1u);
    return b;
}
__device__ __forceinline__ void xcd_barrier_complete(unsigned* bar, unsigned x, unsigned& nloc, unsigned& nx) {
    const unsigned G = gridDim.x * gridDim.y * gridDim.z;
    unsigned sum, cnt, mine, sp = 0u;
    for (;;) {
        sum = 0u; cnt = 0u; mine = 0u;
#pragma unroll
        for (unsigned j = 0; j < 16; ++j) { const unsigned c = xb_ld(&bar[XB_XCNT(j)]); sum += c; cnt += (c > 0u) ? 1u : 0u; mine = (j == x) ? c : mine; }
        if (sum == G) break;
        __builtin_amdgcn_s_sleep(1);
        if ((++sp & 255u) == 0u) { if (xb_ld(&bar[XB_TMO])) break; if (sp > XB_SPIN_CAP) { atomicAdd(&bar[XB_TMO], 1u); break; } }
    }
    nloc = mine > 0u ? mine : 1u; nx = cnt > 0u ? cnt : 1u;
}

__device__ __forceinline__ void xcd_barrier(const XcdBarrier& b) {
    asm volatile("s_waitcnt vmcnt(0)" ::: "memory");
    __syncthreads();
    if (XB_TID == 0) {
        unsigned* bar = b.bar;
        __builtin_amdgcn_s_waitcnt(0);
        unsigned nloc = b.st[0], nx = b.st[1];
        if (nloc == 0u) { xcd_barrier_complete(bar, b.x, nloc, nx); b.st[0] = nloc; b.st[1] = nx; }
        const unsigned old = xb_add(&bar[XB_XSUB(b.x)], 1u);
        const unsigned gen = old / nloc;
        if (old + 1u == (gen + 1u) * nloc) {
            __builtin_amdgcn_fence(__ATOMIC_RELEASE, "agent");
            asm volatile("s_waitcnt vmcnt(0)" ::: "memory");
            const unsigned og = xb_add(&bar[XB_TOP], 1u);
            const unsigned tg = og / nx;
            if (og + 1u == (tg + 1u) * nx) xb_add(&bar[XB_TOPGEN], 1u);
            else XB_SPIN(xb_ld(&bar[XB_TOPGEN]) == tg, bar);
            __builtin_amdgcn_fence(__ATOMIC_ACQUIRE, "agent");
            xb_add(&bar[XB_XGEN(b.x)], 1u);
            asm volatile("s_waitcnt vmcnt(0)" ::: "memory");
        } else {
            XB_SPIN(xb_ld(&bar[XB_XGEN(b.x)]) == gen, bar);
            __builtin_amdgcn_fence(__ATOMIC_ACQUIRE, "agent");
            asm volatile("s_waitcnt vmcnt(0)" ::: "memory");
        }
    }
    __syncthreads();
}


#ifndef GALIGN
#define GALIGN true
#endif
#ifndef GSP2
#define GSP2 true
#endif
template <class Epi>
__device__ __forceinline__ void run_gemm(PG8_LAS unsigned char* lds, const bf16_t* A, const bf16_t* Bt, int K, int M, int N, const bf16_t* A2, const bf16_t* Bt2, int M2, int N2, const Epi& E) {
    A = opq_p(A); Bt = opq_p(Bt); A2 = opq_p(A2); Bt2 = opq_p(Bt2);
    Gemm g; g.A = A; g.Bt = Bt; g.A2 = A2; g.Bt2 = Bt2; g.M = M; g.N = N; g.K = K;
    StaticOrder S; S.init(M, N, K, (int)gridDim.x, (int)BIDX, M2, N2);
#ifndef NO_GEMM
    gemm_phase<Epi, StaticOrder, GALIGN, GSP2>(lds, g, S, E);
#endif
}

struct EpiAny {
    static constexpr bool PERM = false, AFTER_DRAIN = false;
    int kind; bf16_t* C; long ldc; bf16_t* C2; long ldc2; float* X; const float* modl; int idx; float coef; const bf16_t* P1; const float* bg; bf16_t* Gb;
    __device__ __forceinline__ bool hook_on() const { return kind == 3; }
    __device__ __forceinline__ void hook(f32x4 (&acc)[2][2][4][2], const Unit& u, int wr, int wc, int fr, int fq, int kb) const { EpiBranch E; E.P1 = P1; E.bg = bg; E.Gb = Gb; E.hook(acc, u, wr, wc, fr, fq, kb); }
    __device__ __forceinline__ void operator()(const f32x4 (&acc)[2][2][4][2], const Unit& u, int wr, int wc, int fr, int fq) const {
        if (kind == 0) { EpiStore E; E.C = u.split ? C2 : C; E.ldc = u.split ? ldc2 : ldc; E(acc, u, wr, wc, fr, fq); }
        else if (kind == 1) { EpiGateUp E; E.C = C; E(acc, u, wr, wc, fr, fq); }
        else if (kind == 2) { EpiResid E; E.X = X; E.modl = modl; E.idx = idx; E.coef = coef; E(acc, u, wr, wc, fr, fq); }
        else { EpiBranch E; E.P1 = P1; E.bg = bg; E.Gb = Gb; E(acc, u, wr, wc, fr, fq); }
    }
};

__global__ void __launch_bounds__(512, 2) hybrid_fwd(Params p) {
    extern __shared__ __attribute__((aligned(16))) unsigned char lds_raw[];
    PG8_LAS unsigned char* lds = (PG8_LAS unsigned char*)lds_raw;
    PG8_LAS float* lf = (PG8_LAS float*)lds;
    cg::grid_group grid = cg::this_grid();
    __shared__ uint4 xb_words;
    if (threadIdx.x == 0) xb_words = make_uint4(0u, 0u, 0u, 0u);
    __syncthreads();
    const XcdBarrier xbar = xcd_barrier_post((unsigned*)(ws_load() + OFF_BAR), (volatile PG8_LAS unsigned*)&xb_words);
#ifdef NO_SYNC
#define GSYNC() __syncthreads()
#else
#define GSYNC() xcd_barrier(xbar)
#endif
#ifndef NO_P0
    phase_mod(p, lf);
    phase_copy_x(p);
    phase_rope_table();
    convert_layer(p, 0, lf);
#endif
    grid.sync();
#pragma unroll 1
    for (int l0 = 0; l0 < DEPTH; ++l0) {
        int l = opq_i(l0);
#pragma unroll 1
        for (int gi0 = 0; gi0 < 8; ++gi0) {
            int gi = opq_i(gi0);
            unsigned char* ws = ws_load();
            if (gi == 0) {
                phase_ada<false>(p, PIN(p, I_NFFN1) + l * 1024, l, 0, 1, lf);
                GSYNC();
            } else if (gi == 2) {
                phase_ada<true>(p, PIN(p, I_NMIX) + l * 1024, l, 3, 4, lf);
                GSYNC();
            } else if (gi == 4) {
#ifndef NO_PREP
                phase_prep(p, l);
#endif
                GSYNC();
                {
                    PG8_LAS bf16_t* lb = (PG8_LAS bf16_t*)lds;
                    {
                        const int bid = BIDX, G = (int)gridDim.x;
                        if (G == 256) {
                            int a0, step, lim;
                            if (bid < 144) { ssm_a_item(p, l, bid, lf); a0 = 672 + bid; step = 144; lim = 1216; }
                            else { a0 = bid - 144; step = 112; lim = 672; }
                            for (int a = a0; a < lim; a += step) {
                                if (a < 512) wa_block(p, l, a, lb);
                                else if (a < 1024) na_block(p, l, a - 512, lb);
                                else if (l < DEPTH - 1) ctx_block(p, l, a - 1024, lb);
                            }
                        } else {
                            for (int it = bid; it < 144 + 512 + 512 + 192; it += G) {
                                if (it < 144) ssm_a_item(p, l, it, lf);
                                else if (it < 656) wa_block(p, l, it - 144, lb);
                                else if (it < 1168) na_block(p, l, it - 656, lb);
                                else if (l < DEPTH - 1) ctx_block(p, l, it - 1168, lb);
                            }
                        }
                    }
                    GSYNC();
                    phase_ssm_scan(p);
                    GSYNC();
                    {
                        const int bid = BIDX, G = (int)gridDim.x;
                        if (G == 256) {
                            if (bid < 144) { if (l < DEPTH - 1 || (bid % 18) >= 2) ssm_b_item(p, l, bid, lds); ga_block(p, bid, lb); }
                            else { const int j = bid - 144; ga_block(p, 144 + j, lb); ga_block(p, 256 + j, lb); ga_block(p, 368 + j, lb); if (j < 32) ga_block(p, 480 + j, lb); }
                        } else {
                            for (int it = bid; it < 144 + 512; it += G) {
                                if (it < 144) { if (l < DEPTH - 1 || (it % 18) >= 2) ssm_b_item(p, l, it, lds); }
                                else ga_block(p, it - 144, lb);
                            }
                        }
                    }
                    GSYNC();
                }
            } else if (gi == 6) {
                phase_ada<false>(p, PIN(p, I_NFFN2) + l * 1024, l, 6, 7, lf);
                GSYNC();
            }
            bf16_t* H = (bf16_t*)(ws + OFF_H); bf16_t* BIG = (bf16_t*)(ws + OFF_BIG);
            const float* modl = (const float*)(ws + OFF_MOD) + (size_t)l * 9 * 9216;
            const bf16_t* A = H; const bf16_t* Bt = (const bf16_t*)(ws + OFF_WGU1); int K = 1024, M = MT, N = 1024;
            const bf16_t* A2 = H; const bf16_t* Bt2 = H; int M2 = 0, N2 = 0;
            EpiAny E; E.kind = 0; E.C = BIG; E.ldc = P1W; E.C2 = (bf16_t*)(ws + OFF_PT); E.ldc2 = MT; E.X = (float*)(ws + OFF_X); E.modl = modl; E.idx = 2; E.coef = 0.5f;
            E.P1 = BIG; E.bg = PIN(p, I_BGATE) + (size_t)l * 4096; E.Gb = H;
            if (gi == 0) { N = 5632; E.kind = 1; }
            if (gi == 1) { A = BIG; Bt = (const bf16_t*)(ws + OFF_WD1); K = DFF; E.kind = 2; }
            else if (gi == 2) { Bt = (const bf16_t*)(ws + OFF_WIN); N = 6144; A2 = (const bf16_t*)(ws + OFF_WIN) + (size_t)6144 * 1024; Bt2 = H; M2 = 1024; N2 = MT; }
            else if (gi == 3) { continue; }
            if (gi >= 4 && l == DEPTH - 1) M = ML;
            if (gi < 4) { }
            else if (gi == 4) { A = (const bf16_t*)(ws + OFF_Y); Bt = (const bf16_t*)(ws + OFF_WBR); E.kind = 3; }
            else if (gi == 5) { Bt = (const bf16_t*)(ws + OFF_WO); E.kind = 2; E.idx = 5; E.coef = 1.0f; }
            else if (gi == 6) { Bt = (const bf16_t*)(ws + OFF_WGU2); N = 5632; E.kind = 1; }
            else { A = BIG; Bt = (const bf16_t*)(ws + OFF_WD2); K = DFF; E.kind = 2; E.idx = 8; }
            run_gemm(lds, A, Bt, K, M, N, A2, Bt2, M2, N2, E);
            if (gridDim.x == 256) {
                if (gi == 4 && l < DEPTH - 1) convert_layer(p, l + 1, lf, 0, 976, 32);
                if (gi == 0 && l > 0) convert_layer(p, l, lf, 976, 1632, 48);
            } else {
                if (gi == 4 && l < DEPTH - 1) { __syncthreads(); convert_layer(p, l + 1, lf, 0, 976, 0); }
                if (gi == 0 && l > 0) { __syncthreads(); convert_layer(p, l, lf, 976, 1632, 0); }
            }
            GSYNC();
        }
    }
    phase_final(p);
}

extern "C" void kernel_launch(void* const* d_in, const int* in_sizes, int n_in, void* d_out, int out_size, void* d_ws, size_t ws_size, hipStream_t stream) {
    static int grid_blocks = 0;
    if (!grid_blocks) {
        if (hipFuncSetAttribute((const void*)hybrid_fwd, hipFuncAttributeMaxDynamicSharedMemorySize, LDS_BYTES) != hipSuccess) fprintf(stderr, "hipFuncSetAttribute failed\n");
        int dev = 0, cus = 0, per_cu = 0;
        hipGetDevice(&dev);
        hipDeviceGetAttribute(&cus, hipDeviceAttributeMultiprocessorCount, dev);
        hipOccupancyMaxActiveBlocksPerMultiprocessor(&per_cu, hybrid_fwd, 512, LDS_BYTES);
        if (per_cu < 1) per_cu = 1;
        if (per_cu > 1) per_cu = 1;
        grid_blocks = cus * per_cu;
        if (ws_size < WS_END) fprintf(stderr, "workspace too small: %zu < %zu\n", ws_size, (size_t)WS_END);
    }
    Params p{};
    for (int i = 0; i < 30; ++i) p.in[i] = (const float*)d_in[i];
    p.out = (float*)d_out; p.ws = (unsigned char*)d_ws;
    (void)hipMemsetAsync((unsigned char*)d_ws + OFF_BAR, 0, 16384, stream);
    void* args[] = {&p};
    hipError_t e = hipLaunchCooperativeKernel((void*)hybrid_fwd, dim3(grid_blocks), dim3(512), args, LDS_BYTES, stream);
    if (e != hipSuccess) fprintf(stderr, "cooperative launch failed: %s (grid %d)\n", hipGetErrorString(e), grid_blocks);
}
```
